# Optimizing an MI355X kernel written in HIP

```python
import jax, jax.numpy as jnp
from jax import lax
import numpy as np

D_MODEL = 1024
BATCH = 8
SEQ = 4096
DEPTH = 1

RET_HEADS = 4
RET_DK = 128
RET_DV = 128
RET_CHUNK = 128
RET_W = RET_HEADS * RET_DK
RET_VW = RET_HEADS * RET_DV
ATT_Q_HEADS = 8
ATT_KV_HEADS = 2
ATT_HD = 64
ATT_QW = ATT_Q_HEADS * ATT_HD
ATT_KVW = ATT_KV_HEADS * ATT_HD
WINDOW = 128
ATT_BLOCK = 128
ROPE_THETA = 10000.0
D_FF = 2752
EPS = 1e-6
IN_SIZES = (RET_W, RET_W, RET_VW, RET_VW, ATT_QW, ATT_KVW, ATT_KVW, D_MODEL, D_MODEL)
IN_COLS = sum(IN_SIZES)
IN_SPLITS = tuple(int(v) for v in np.cumsum(IN_SIZES)[:-1])

kernel_name = "hybrid_retention_swa_macaron_block"


def rmsnorm(x, g):
    xf = x.astype(jnp.float32)
    y = xf * lax.rsqrt(jnp.mean(xf * xf, axis=-1, keepdims=True) + EPS)
    return (y * g.astype(jnp.float32)).astype(x.dtype)


def rope(x):
    s, d = x.shape[1], x.shape[-1]
    half = d // 2
    inv_freq = ROPE_THETA ** (-jnp.arange(half, dtype=jnp.float32) / half)
    ang = jnp.arange(s, dtype=jnp.float32)[:, None] * inv_freq[None, :]
    cos = jnp.cos(ang)[None, :, None, :].astype(x.dtype)
    sin = jnp.sin(ang)[None, :, None, :].astype(x.dtype)
    x1, x2 = x[..., :half], x[..., half:]
    return jnp.concatenate([x1 * cos - x2 * sin, x1 * sin + x2 * cos], axis=-1)


def swiglu(x, w_in, w_out):
    gu = x @ w_in
    g, u = jnp.split(gu, 2, axis=-1)
    return (jax.nn.silu(g) * u) @ w_out


def retention_dir(q, k, v, log_gamma, include_diag):
    b, h, s, dk = q.shape
    dv = v.shape[-1]
    c = RET_CHUNK
    nc = s // c
    lg = log_gamma.astype(jnp.float32)
    idx = jnp.arange(c, dtype=jnp.float32)
    rel = idx[:, None] - idx[None, :]
    mask = (rel >= 0) if include_diag else (rel > 0)
    d_in = jnp.where(mask[None], jnp.exp(jnp.maximum(rel, 0.0)[None] * lg[:, None, None]), 0.0).astype(q.dtype)
    qc = q.reshape(b, h, nc, c, dk)
    kc = k.reshape(b, h, nc, c, dk)
    vc = v.reshape(b, h, nc, c, dv)
    scores = jnp.einsum('bhncd,bhnkd->bhnck', qc, kc) * d_in[None, :, None]
    inner = jnp.einsum('bhnck,bhnke->bhnce', scores, vc)
    k_dec = jnp.exp((c - 1 - idx)[None, :] * lg[:, None]).astype(q.dtype)
    kv = jnp.einsum('bhnkd,bhnke->nbhde', kc * k_dec[None, :, None, :, None], vc)
    g_c = jnp.exp(c * lg).astype(kv.dtype)[:, None, None]

    def step(state, kv_n):
        return g_c * state + kv_n, state

    _, states = lax.scan(step, jnp.zeros_like(kv[0]), kv)
    q_dec = jnp.exp((idx + 1.0)[None, :] * lg[:, None]).astype(q.dtype)
    cross = jnp.einsum('bhncd,nbhde->bhnce', qc * q_dec[None, :, None, :, None], states)
    return (inner + cross).reshape(b, h, s, dv)


def retention_branch(q, k, v, g, decay_fwd, decay_bwd, gn_gain, w_o):
    b, s = q.shape[0], q.shape[1]
    q = jnp.transpose(rope(q), (0, 2, 1, 3))
    k = jnp.transpose(rope(k) * (RET_DK ** -0.5), (0, 2, 1, 3))
    v = jnp.transpose(v, (0, 2, 1, 3))
    lg_f = -jnp.exp(decay_fwd.astype(jnp.float32))
    lg_b = -jnp.exp(decay_bwd.astype(jnp.float32))
    y_f = retention_dir(q, k, v, lg_f, True)
    y_b = retention_dir(q[:, :, ::-1], k[:, :, ::-1], v[:, :, ::-1], lg_b, False)[:, :, ::-1]
    y = (y_f + y_b).astype(jnp.float32)
    mu = jnp.mean(y, axis=-1, keepdims=True)
    var = jnp.mean(jnp.square(y - mu), axis=-1, keepdims=True)
    y = (y - mu) * lax.rsqrt(var + EPS)
    y = jnp.transpose(y, (0, 2, 1, 3)).reshape(b, s, RET_VW) * gn_gain.astype(jnp.float32)
    y = y.astype(g.dtype) * jax.nn.silu(g)
    return y @ w_o


def window_attention_branch(q, k, v, sink, w_o):
    b, s = q.shape[0], q.shape[1]
    nb = s // ATT_BLOCK
    grp = ATT_Q_HEADS // ATT_KV_HEADS
    q = rope(q)
    k = rope(k)
    qb = q.reshape(b, nb, ATT_BLOCK, ATT_KV_HEADS, grp, ATT_HD)
    pad = ((0, 0), (ATT_BLOCK, ATT_BLOCK), (0, 0), (0, 0))
    kp = jnp.pad(k, pad).reshape(b, nb + 2, ATT_BLOCK, ATT_KV_HEADS, ATT_HD)
    vp = jnp.pad(v, pad).reshape(b, nb + 2, ATT_BLOCK, ATT_KV_HEADS, ATT_HD)
    kb = jnp.concatenate([kp[:, :-2], kp[:, 1:-1], kp[:, 2:]], axis=2)
    vb = jnp.concatenate([vp[:, :-2], vp[:, 1:-1], vp[:, 2:]], axis=2)
    sc = jnp.einsum('bnqhgd,bnkhd->bnhgqk', qb, kb).astype(jnp.float32) * (ATT_HD ** -0.5)
    blk = jnp.arange(nb)
    qpos = blk[:, None] * ATT_BLOCK + jnp.arange(ATT_BLOCK)[None, :]
    kpos = (blk[:, None] - 1) * ATT_BLOCK + jnp.arange(3 * ATT_BLOCK)[None, :]
    valid = (jnp.abs(qpos[:, :, None] - kpos[:, None, :]) <= WINDOW) \
        & (kpos >= 0)[:, None, :] & (kpos < s)[:, None, :]
    sc = jnp.where(valid[None, :, None, None], sc, -jnp.inf)
    snk = sink.astype(jnp.float32).reshape(1, 1, ATT_KV_HEADS, grp, 1, 1)
    m = jnp.maximum(jnp.max(sc, axis=-1, keepdims=True), snk)
    p = jnp.exp(sc - m)
    p = p / (jnp.sum(p, axis=-1, keepdims=True) + jnp.exp(snk - m))
    o = jnp.einsum('bnhgqk,bnkhd->bnqhgd', p.astype(vb.dtype), vb).reshape(b, s, ATT_QW)
    return o @ w_o


def setup_inputs(seed: int = 0) -> dict:
    key = jax.random.key(seed)
    ks = jax.random.split(key, 20)

    def w(k, shape, fan_in):
        return jax.random.normal(k, shape, jnp.float32) * (fan_in ** -0.5)

    def gain(k, n):
        return 1.0 + 0.02 * jax.random.normal(k, (DEPTH, n), jnp.float32)

    base_decay = np.log(-np.log(1.0 - 2.0 ** (-5.0 - np.arange(RET_HEADS)))).astype(np.float32)
    x = jax.random.normal(ks[0], (BATCH, SEQ, D_MODEL), jnp.float32)
    return {
        "x": x,
        "norm_ffn1": gain(ks[1], D_MODEL),
        "ffn1_w_in": w(ks[2], (DEPTH, D_MODEL, 2 * D_FF), D_MODEL),
        "ffn1_w_out": w(ks[3], (DEPTH, D_FF, D_MODEL), D_FF),
        "norm_mix": gain(ks[4], D_MODEL),
        "w_in": w(ks[5], (DEPTH, D_MODEL, IN_COLS), D_MODEL),
        "ret_decay_fwd": jnp.asarray(base_decay)[None] + 0.05 * jax.random.normal(ks[6], (DEPTH, RET_HEADS), jnp.float32),
        "ret_decay_bwd": jnp.asarray(base_decay)[None] + 0.05 * jax.random.normal(ks[7], (DEPTH, RET_HEADS), jnp.float32),
        "ret_gn_gain": gain(ks[8], RET_VW),
        "w_ret_out": w(ks[9], (DEPTH, RET_VW, D_MODEL), RET_VW),
        "att_sink": 0.5 * jax.random.normal(ks[10], (DEPTH, ATT_Q_HEADS), jnp.float32),
        "w_att_out": w(ks[11], (DEPTH, ATT_QW, D_MODEL), ATT_QW),
        "w_out": w(ks[12], (DEPTH, D_MODEL, D_MODEL), D_MODEL),
        "norm_ffn2": gain(ks[13], D_MODEL),
        "ffn2_w_in": w(ks[14], (DEPTH, D_MODEL, 2 * D_FF), D_MODEL),
        "ffn2_w_out": w(ks[15], (DEPTH, D_FF, D_MODEL), D_FF),
        "norm_final": 1.0 + 0.02 * jax.random.normal(ks[16], (D_MODEL,), jnp.float32),
    }


def reference(x, norm_ffn1, ffn1_w_in, ffn1_w_out, norm_mix, w_in, ret_decay_fwd, ret_decay_bwd,
              ret_gn_gain, w_ret_out, att_sink, w_att_out, w_out, norm_ffn2, ffn2_w_in, ffn2_w_out,
              norm_final):
    b, s, _ = x.shape
    for l in range(DEPTH):
        x = x + 0.5 * swiglu(rmsnorm(x, norm_ffn1[l]), ffn1_w_in[l], ffn1_w_out[l])
        h = rmsnorm(x, norm_mix[l])
        proj = h @ w_in[l]
        q_r, k_r, v_r, g_r, q_a, k_a, v_a, gate_r, gate_a = jnp.split(proj, IN_SPLITS, axis=-1)
        y_ret = retention_branch(
            q_r.reshape(b, s, RET_HEADS, RET_DK), k_r.reshape(b, s, RET_HEADS, RET_DK),
            v_r.reshape(b, s, RET_HEADS, RET_DV), g_r,
            ret_decay_fwd[l], ret_decay_bwd[l], ret_gn_gain[l], w_ret_out[l])
        y_att = window_attention_branch(
            q_a.reshape(b, s, ATT_Q_HEADS, ATT_HD), k_a.reshape(b, s, ATT_KV_HEADS, ATT_HD),
            v_a.reshape(b, s, ATT_KV_HEADS, ATT_HD), att_sink[l], w_att_out[l])
        merged = jax.nn.sigmoid(gate_r) * y_ret + jax.nn.sigmoid(gate_a) * y_att
        x = x + merged @ w_out[l]
        x = x + 0.5 * swiglu(rmsnorm(x, norm_ffn2[l]), ffn2_w_in[l], ffn2_w_out[l])
    return rmsnorm(x, norm_final)
```

```cpp
#include <hip/hip_runtime.h>
#include <hip/hip_cooperative_groups.h>
#include <cstdio>
#include <cstdint>
namespace cg = cooperative_groups;

#define LAS __attribute__((address_space(3)))
typedef unsigned short bf16_t;
typedef short bf16x8 __attribute__((ext_vector_type(8)));
typedef short bf16x4 __attribute__((ext_vector_type(4)));
typedef float f32x4 __attribute__((ext_vector_type(4)));
typedef float f32x2 __attribute__((ext_vector_type(2)));
typedef unsigned u32x4 __attribute__((ext_vector_type(4)));
typedef unsigned u32x2 __attribute__((ext_vector_type(2)));

constexpr int T = 32768, D = 1024, FF = 2752, FFP = 2816, NFF2 = 5632, NIN = 4864, SEQ = 4096;
constexpr float EPS = 1e-6f;

constexpr size_t MiB = 1u << 20;
constexpr size_t OFF_W1T = 0;
constexpr size_t OFF_W2T = 11 * MiB;
constexpr size_t OFF_W1O = 22 * MiB;
constexpr size_t OFF_W2O = OFF_W1O + 5767168;
constexpr size_t OFF_WIN = 33 * MiB;
constexpr size_t OFF_WRET = OFF_WIN + 9961472;
constexpr size_t OFF_WATT = OFF_WRET + 1 * MiB;
constexpr size_t OFF_WOUT = OFF_WATT + 1 * MiB;
constexpr size_t OFF_TABR = OFF_WOUT + 2 * MiB;
constexpr size_t OFF_TABA = OFF_TABR + 2 * MiB;
constexpr size_t OFF_DT = OFF_TABA + 1 * MiB;
constexpr size_t OFF_SM = OFF_DT + 16384;
constexpr size_t OFF_SS = OFF_DT + 65536;
constexpr size_t OFF_XB = 51 * MiB;
constexpr size_t OFF_BIG = 115 * MiB;
constexpr size_t OFF_QR = OFF_BIG;
constexpr size_t OFF_KR = OFF_QR + 32 * MiB;
constexpr size_t OFF_KFT = OFF_KR + 32 * MiB;
constexpr size_t OFF_KBT = OFF_KFT + 32 * MiB;
constexpr size_t OFF_VRT = OFF_KBT + 32 * MiB;
constexpr size_t OFF_GR = OFF_VRT + 32 * MiB;
constexpr size_t OFF_QA = OFF_GR + 32 * MiB;
constexpr size_t OFF_KA = OFF_QA + 32 * MiB;
constexpr size_t OFF_VAT = OFF_KA + 8 * MiB;
constexpr size_t OFF_SR = OFF_VAT + 8 * MiB;
constexpr size_t OFF_SA = OFF_SR + 64 * MiB;
constexpr size_t OFF_MG = OFF_KR;
constexpr size_t OFF_BARW = OFF_SA + 64 * MiB;
constexpr size_t WS_END = OFF_BARW + 16384;
static_assert(OFF_SS + 4 * T * 4 <= OFF_XB, "ws map");
static_assert(OFF_BIG + (size_t)T * FFP * 2 <= WS_END, "ws map H");

struct Params {
    const float* x; const float* g1; const float* w1i; const float* w1o; const float* gmix; const float* win;
    const float* dfw; const float* dbw; const float* gng; const float* wret; const float* sink; const float* watt;
    const float* wout; const float* g2; const float* w2i; const float* w2o; const float* gfin;
    float* out; unsigned char* ws;
};

typedef __bf16 bf16v2_t __attribute__((ext_vector_type(2)));
__device__ __forceinline__ unsigned cvt_pk_bf16(float lo, float hi) { const f32x2 v = {lo, hi}; const bf16v2_t r = __builtin_convertvector(v, bf16v2_t); return __builtin_bit_cast(unsigned, r); }
__device__ __forceinline__ float bf2f(unsigned short b) { return __uint_as_float(((unsigned)b) << 16); }
__device__ __forceinline__ float bflo(unsigned w) { return __uint_as_float(w << 16); }
__device__ __forceinline__ float bfhi(unsigned w) { return __uint_as_float(w & 0xffff0000u); }
__device__ __forceinline__ unsigned short f2bf(float f) { unsigned u = __float_as_uint(f); return (unsigned short)((u + 0x7fffu + ((u >> 16) & 1u)) >> 16); }
__device__ __forceinline__ float sigm(float v) { return __builtin_amdgcn_rcpf(1.f + __expf(-v)); }
__device__ __forceinline__ u32x4 pack8(const float* v) { u32x4 w; w.x = cvt_pk_bf16(v[0], v[1]); w.y = cvt_pk_bf16(v[2], v[3]); w.z = cvt_pk_bf16(v[4], v[5]); w.w = cvt_pk_bf16(v[6], v[7]); return w; }
#define MFMA16(a, b, c) __builtin_amdgcn_mfma_f32_16x16x32_bf16((a), (b), (c), 0, 0, 0)

namespace pg8 {
constexpr int BM = 256, BK = 64, HALF = 128, HTB = HALF * BK * 2, STAGE_BYTES = 8 * HTB, NXCD = 8, WGM = 8;
__host__ __device__ __forceinline__ int lds_byte(int r, int c) { const int st = (r >> 4) * 2 + (c >> 5), rr = r & 15, cc = c & 31, ob = rr * 64 + cc * 2; return st * 1024 + (ob ^ (((ob >> 9) & 1) << 5)); }
__host__ __device__ __forceinline__ void stage_rc(int b, int& R, int& C) { const int st = b / 1024, sb = b % 1024, swz = sb ^ (((sb >> 9) & 1) << 5); R = (st >> 1) * 16 + swz / 64; C = (st & 1) * 32 + (swz % 64) / 2; }
__host__ __device__ __forceinline__ int perm32(int rho) { const int n = rho >> 4, i = rho & 15; return 8 * (i >> 2) + 4 * n + (i & 3); }

struct Unit { int pm, pn, hsel, half; };
struct Gemm { const bf16_t* A; const bf16_t* Bt; int M, N, K; };

struct StaticOrder {
    int nM, nN, nwg, G, c;
    __host__ __device__ void init(int M, int N, int G_, int c_) { nM = M / BM; nN = N / BM; nwg = nM * nN; G = G_; c = c_; }
    __host__ __device__ bool next(int i, Unit& u) const {
        const long L = (long)i * G + c; if (L >= nwg) return false;
        int wgid = (int)L; { const int q = nwg / NXCD, r = nwg % NXCD, xcd = wgid % NXCD, off = wgid / NXCD; wgid = (xcd < r ? xcd * (q + 1) : r * (q + 1) + (xcd - r) * q) + off; }
        const int nig = WGM * nN, gid = wgid / nig, fm = gid * WGM, gsz = (nM - fm) < WGM ? (nM - fm) : WGM;
        u.pm = fm + ((wgid % nig) % gsz); u.pn = (wgid % nig) / gsz; u.hsel = 0; u.half = 0; return true;
    }
};

struct TailSplitOrder {
    StaticOrder S;
    __host__ __device__ bool next(int i, Unit& u) const {
        const int full = S.nwg / S.G, rem = S.nwg - full * S.G;
        if (i < full || 2 * rem != S.G) return S.next(i, u);
        if (i > full) return false;
        StaticOrder S2 = S; S2.c = S.c % rem;
        if (!S2.next(full, u)) return false;
        u.hsel = S.c / rem; u.half = 1; return true;
    }
};

template <class Epi, class Order>
__device__ __forceinline__ void gemm_phase(LAS unsigned char* lds, const Gemm g, const Order& S, const Epi& E) {
    int tid = threadIdx.x; asm volatile("" : "+v"(tid));
    const int wid = __builtin_amdgcn_readfirstlane(tid >> 6), lane = tid & 63, wr = wid >> 2, wc = wid & 3, fr = lane & 15, fq = lane >> 4;
    const int K = g.K, nt = K / BK;
    unsigned voffA[2], voffB[2];
#pragma unroll
    for (int i = 0; i < 2; ++i) { int R, C; stage_rc(tid * 16 + i * 8192, R, C); const int Rb = (R & ~31) + perm32(R & 31);
        voffA[i] = (unsigned)(R * K + C) * 2u; voffB[i] = (unsigned)(Rb * K + C) * 2u; }
    const size_t kstep = (size_t)(BK * 2);
    const size_t hstep = (size_t)HALF * K * 2;
    const size_t tstep = 2 * hstep;
    const unsigned ldsw = (unsigned)wid * 1024u;
    const int aoff = lds_byte(wr * 64 + fr, fq * 8), boff = lds_byte(wc * 32 + fr, fq * 8);
#define PG8_SA(b, h) (((b) * 2 + (h)) * HTB)
#define PG8_SB(b, h) ((4 + (b) * 2 + (h)) * HTB)
#define PG8_STAGE(bufoff, gbase, voff) do { _Pragma("unroll") for (int _i = 0; _i < 2; ++_i) \
        __builtin_amdgcn_global_load_lds((const unsigned*)((const char*)(gbase) + (voff)[_i]), (LAS unsigned*)(lds + (bufoff) + ldsw + _i * 8192), 16, 0, 0); } while (0)
#define PG8_LDA(dst, b, h) do { _Pragma("unroll") for (int m = 0; m < 4; ++m) _Pragma("unroll") for (int k = 0; k < 2; ++k) dst[m][k] = *(const LAS bf16x8*)(lds + PG8_SA(b, h) + aoff + m * 2048 + k * 1024); } while (0)
#define PG8_LDB(dst, b, h) do { _Pragma("unroll") for (int n = 0; n < 2; ++n) _Pragma("unroll") for (int k = 0; k < 2; ++k) dst[n][k] = *(const LAS bf16x8*)(lds + PG8_SB(b, h) + boff + n * 2048 + k * 1024); } while (0)
#define PG8_MMA(ai, bj, At, Bt) do { __builtin_amdgcn_s_setprio(1); _Pragma("unroll") for (int m = 0; m < 4; ++m) _Pragma("unroll") for (int n = 0; n < 2; ++n) _Pragma("unroll") for (int k = 0; k < 2; ++k) \
        acc[ai][bj][m][n] = __builtin_amdgcn_mfma_f32_16x16x32_bf16(Bt[n][k], At[m][k], acc[ai][bj][m][n], 0, 0, 0); __builtin_amdgcn_s_setprio(0); } while (0)
#define PG8_WAIT_V(n) asm volatile("s_waitcnt vmcnt(" #n ")" ::: "memory")
#define PG8_WAIT_L(n) asm volatile("s_waitcnt lgkmcnt(" #n ")" ::: "memory")
#define PG8_BAR __builtin_amdgcn_s_barrier()
#define PG8_SCHED __builtin_amdgcn_sched_barrier(0)
    Unit cur, nxt; int ui = 0;
    if (!S.next(0, cur)) return;
    f32x4 acc[2][2][4][2];
#pragma unroll
    for (int a = 0; a < 2; ++a)
#pragma unroll
        for (int b = 0; b < 2; ++b)
#pragma unroll
            for (int m = 0; m < 4; ++m)
#pragma unroll
                for (int n = 0; n < 2; ++n) acc[a][b][m][n] = (f32x4){0.f, 0.f, 0.f, 0.f};
    bf16x8 At[4][2], B0[2][2], B1[2][2];
    const char* cA = (const char*)g.A + (size_t)cur.pm * tstep + (size_t)cur.hsel * hstep; const char* cB = (const char*)g.Bt + (size_t)cur.pn * tstep;
    PG8_STAGE(PG8_SB(0, 0), cB, voffB); PG8_STAGE(PG8_SB(0, 1), cB + hstep, voffB); PG8_STAGE(PG8_SA(0, 0), cA, voffA); PG8_STAGE(PG8_SA(0, 1), cA + hstep, voffA);
    if (wr == 1) PG8_BAR;
    PG8_WAIT_V(2); PG8_BAR;
    PG8_STAGE(PG8_SB(1, 0), cB + kstep, voffB); PG8_STAGE(PG8_SA(1, 0), cA + kstep, voffA); PG8_STAGE(PG8_SB(1, 1), cB + hstep + kstep, voffB);
    PG8_WAIT_V(6); PG8_BAR;
    for (;;) {
        const bool has_next = S.next(ui + 1, nxt);
        const char* nA = has_next ? (const char*)g.A + (size_t)nxt.pm * tstep + (size_t)nxt.hsel * hstep : cA; const char* nB = has_next ? (const char*)g.Bt + (size_t)nxt.pn * tstep : cB;
        for (int t = 0; t < nt; t += 2) {
            const bool last = (t == nt - 2);
            const char* a1 = cA + (size_t)(t + 1) * kstep;
            const char* a2 = last ? nA : cA + (size_t)(t + 2) * kstep; const char* b2 = last ? nB : cB + (size_t)(t + 2) * kstep;
            const char* a3 = a2 + kstep; const char* b3 = b2 + kstep;
            PG8_LDB(B0, 0, 0); PG8_LDB(B1, 0, 1); PG8_SCHED; PG8_LDA(At, 0, 0); PG8_STAGE(PG8_SA(1, 1), a1 + hstep, voffA);
            PG8_WAIT_V(8); PG8_WAIT_L(0); PG8_BAR; PG8_MMA(0, 0, At, B0); PG8_MMA(0, 1, At, B1); PG8_BAR; PG8_SCHED;
            PG8_LDA(At, 0, 1); PG8_STAGE(PG8_SB(0, 0), b2, voffB); PG8_STAGE(PG8_SB(0, 1), b2 + hstep, voffB); PG8_STAGE(PG8_SA(0, 0), a2, voffA);
            PG8_WAIT_V(8); PG8_WAIT_L(0); PG8_BAR; if (!cur.half) { PG8_MMA(1, 0, At, B0); PG8_MMA(1, 1, At, B1); } PG8_BAR; PG8_SCHED;
            PG8_LDB(B0, 1, 0); PG8_LDB(B1, 1, 1); PG8_SCHED; PG8_LDA(At, 1, 0); PG8_STAGE(PG8_SA(0, 1), a2 + hstep, voffA);
            PG8_WAIT_V(8); PG8_WAIT_L(0); PG8_BAR; PG8_MMA(0, 0, At, B0); PG8_MMA(0, 1, At, B1); PG8_BAR; PG8_SCHED;
            PG8_LDA(At, 1, 1); PG8_STAGE(PG8_SB(1, 0), b3, voffB); PG8_STAGE(PG8_SB(1, 1), b3 + hstep, voffB); PG8_STAGE(PG8_SA(1, 0), a3, voffA);
            PG8_WAIT_V(8); PG8_WAIT_L(0); PG8_BAR; if (!cur.half) { PG8_MMA(1, 0, At, B0); PG8_MMA(1, 1, At, B1); } PG8_BAR; PG8_SCHED;
        }
        if (wr == 0) PG8_BAR;
        E(acc, cur, wr, wc, fr, fq);
        if (!has_next) break;
#pragma unroll
        for (int a = 0; a < 2; ++a)
#pragma unroll
            for (int b = 0; b < 2; ++b)
#pragma unroll
                for (int m = 0; m < 4; ++m)
#pragma unroll
                    for (int n = 0; n < 2; ++n) acc[a][b][m][n] = (f32x4){0.f, 0.f, 0.f, 0.f};
        cur = nxt; cA = nA; cB = nB; ++ui;
        if (wr == 1) PG8_BAR;
    }
    PG8_WAIT_V(0);
    PG8_BAR;
#undef PG8_SA
#undef PG8_SB
#undef PG8_STAGE
#undef PG8_LDA
#undef PG8_LDB
#undef PG8_MMA
#undef PG8_WAIT_V
#undef PG8_WAIT_L
#undef PG8_BAR
#undef PG8_SCHED
}
}
using pg8::Unit;

#define ACC_T const f32x4 (&acc)[2][2][4][2]

struct EpiSwiglu {
    unsigned char* ws; int ssi;
    __device__ __forceinline__ void operator()(ACC_T, const Unit& u, int wr, int wc, int fr, int fq) const {
        const int p0 = wc * 32 + 8 * fq;
        bf16_t* H = (bf16_t*)(ws + OFF_BIG); const float* ss = (const float*)(ws + OFF_SS) + (size_t)ssi * T;
        float rs[8];
#pragma unroll
        for (int i = 0; i < 8; ++i) rs[i] = ss[u.pm * 256 + (i >> 2) * 128 + wr * 64 + (i & 3) * 16 + fr];
#pragma unroll
        for (int ai = 0; ai < 2; ++ai)
#pragma unroll
            for (int m = 0; m < 4; ++m) {
                const int row = u.pm * 256 + ai * 128 + wr * 64 + m * 16 + fr;
                const float rstd = rsqrtf(rs[ai * 4 + m] * (1.f / 1024.f) + EPS);
                float h[8];
#pragma unroll
                for (int n = 0; n < 2; ++n)
#pragma unroll
                    for (int e = 0; e < 4; ++e) { const float gv = acc[ai][0][m][n][e] * rstd, uv = acc[ai][1][m][n][e] * rstd; h[4 * n + e] = gv * sigm(gv) * uv; }
                __builtin_nontemporal_store(pack8(h), (u32x4*)(H + (size_t)row * FFP + u.pn * 128 + p0));
            }
    }
};

template <bool BASE_F32> struct EpiResid {
    const float* basef; unsigned char* ws; int ssi; float scale;
    __device__ __forceinline__ void operator()(ACC_T, const Unit& u, int wr, int wc, int fr, int fq) const {
        const int p0 = wc * 32 + 8 * fq;
        bf16_t* xb = (bf16_t*)(ws + OFF_XB); float* ss = (float*)(ws + OFF_SS) + (size_t)ssi * T;
#pragma unroll
        for (int ai = 0; ai < 2; ++ai) {
            f32x4 bb[4][2][2];
#pragma unroll
            for (int m = 0; m < 4; ++m)
#pragma unroll
                for (int bj = 0; bj < 2; ++bj) { const size_t off = (size_t)(u.pm * 256 + ai * 128 + wr * 64 + m * 16 + fr) * D + u.pn * 256 + bj * 128 + p0;
                    if (BASE_F32) { bb[m][bj][0] = *(const f32x4*)(basef + off); bb[m][bj][1] = *(const f32x4*)(basef + off + 4); }
                    else { const u32x4 bw = *(const u32x4*)(xb + off); bb[m][bj][0] = __builtin_bit_cast(f32x4, bw); } }
            float sqm[4];
#pragma unroll
            for (int m = 0; m < 4; ++m) {
                const int row = u.pm * 256 + ai * 128 + wr * 64 + m * 16 + fr;
                float sq = 0.f;
#pragma unroll
                for (int bj = 0; bj < 2; ++bj) {
                    const size_t off = (size_t)row * D + u.pn * 256 + bj * 128 + p0;
                    f32x4 b0, b1;
                    if (BASE_F32) { b0 = bb[m][bj][0]; b1 = bb[m][bj][1]; }
                    else { const u32x4 bw = __builtin_bit_cast(u32x4, bb[m][bj][0]); b0 = (f32x4){bflo(bw.x), bfhi(bw.x), bflo(bw.y), bfhi(bw.y)}; b1 = (f32x4){bflo(bw.z), bfhi(bw.z), bflo(bw.w), bfhi(bw.w)}; }
                    const f32x4 o0 = b0 + acc[ai][bj][m][0] * scale, o1 = b1 + acc[ai][bj][m][1] * scale;
                    sq += (o0[0] * o0[0] + o0[1] * o0[1]) + (o0[2] * o0[2] + o0[3] * o0[3]) + (o1[0] * o1[0] + o1[1] * o1[1]) + (o1[2] * o1[2] + o1[3] * o1[3]);
                    u32x4 w; w.x = cvt_pk_bf16(o0[0], o0[1]); w.y = cvt_pk_bf16(o0[2], o0[3]); w.z = cvt_pk_bf16(o1[0], o1[1]); w.w = cvt_pk_bf16(o1[2], o1[3]); *(u32x4*)(xb + off) = w;
                }
                sq += __shfl_xor(sq, 16); sq += __shfl_xor(sq, 32);
                sqm[m] = sq;
            }
            const float v = fq == 0 ? sqm[0] : fq == 1 ? sqm[1] : fq == 2 ? sqm[2] : sqm[3];
            atomicAdd(ss + (u.pm * 256 + ai * 128 + wr * 64 + fq * 16 + fr), v);
        }
    }
};

template <bool SECOND> struct EpiGate {
    unsigned char* ws;
    __device__ __forceinline__ void operator()(ACC_T, const Unit& u, int wr, int wc, int fr, int fq) const {
        const int p0 = wc * 32 + 8 * fq;
        bf16_t* MG = (bf16_t*)(ws + OFF_MG); const unsigned char* gate = (const unsigned char*)(ws + (SECOND ? OFF_SA : OFF_SR));
#pragma unroll
        for (int ai = 0; ai < 2; ++ai) {
            u32x2 gwv[4][2]; u32x4 pwv[4][2];
#pragma unroll
            for (int m = 0; m < 4; ++m)
#pragma unroll
                for (int bj = 0; bj < 2; ++bj) { const size_t off = (size_t)(u.pm * 256 + ai * 128 + wr * 64 + m * 16 + fr) * D + u.pn * 256 + bj * 128 + p0;
                    gwv[m][bj] = *(const u32x2*)(gate + off); if (SECOND) pwv[m][bj] = *(const u32x4*)(MG + off); }
#pragma unroll
            for (int m = 0; m < 4; ++m) {
                const int row = u.pm * 256 + ai * 128 + wr * 64 + m * 16 + fr;
#pragma unroll
                for (int bj = 0; bj < 2; ++bj) {
                    const size_t off = (size_t)row * D + u.pn * 256 + bj * 128 + p0;
                    const u32x2 gw = gwv[m][bj]; const float q = 1.f / 255.f;
                    float v[8];
                    v[0] = acc[ai][bj][m][0][0] * ((float)(gw.x & 0xffu) * q); v[1] = acc[ai][bj][m][0][1] * ((float)((gw.x >> 8) & 0xffu) * q);
                    v[2] = acc[ai][bj][m][0][2] * ((float)((gw.x >> 16) & 0xffu) * q); v[3] = acc[ai][bj][m][0][3] * ((float)(gw.x >> 24) * q);
                    v[4] = acc[ai][bj][m][1][0] * ((float)(gw.y & 0xffu) * q); v[5] = acc[ai][bj][m][1][1] * ((float)((gw.y >> 8) & 0xffu) * q);
                    v[6] = acc[ai][bj][m][1][2] * ((float)((gw.y >> 16) & 0xffu) * q); v[7] = acc[ai][bj][m][1][3] * ((float)(gw.y >> 24) * q);
                    if (SECOND) { const u32x4 pw = pwv[m][bj];
                        v[0] += bflo(pw.x); v[1] += bfhi(pw.x); v[2] += bflo(pw.y); v[3] += bfhi(pw.y); v[4] += bflo(pw.z); v[5] += bfhi(pw.z); v[6] += bflo(pw.w); v[7] += bfhi(pw.w); }
                    *(u32x4*)(MG + off) = pack8(v);
                }
            }
        }
    }
};

struct EpiProj {
    unsigned char* ws;
    __device__ __forceinline__ void operator()(ACC_T, const Unit& u, int wr, int wc, int fr, int fq) const {
        asm volatile("" : "+v"(fr), "+v"(fq));
        const int pn = u.pn, p0 = wc * 32 + 8 * fq;
        const float* ss = (const float*)(ws + OFF_SS) + T; const f32x4* tabR = (const f32x4*)(ws + OFF_TABR); const f32x4* tabA = (const f32x4*)(ws + OFF_TABA); const f32x4* dt = (const f32x4*)(ws + OFF_DT);
        bf16_t *QR = (bf16_t*)(ws + OFF_QR), *KR = (bf16_t*)(ws + OFF_KR), *KFT = (bf16_t*)(ws + OFF_KFT), *KBT = (bf16_t*)(ws + OFF_KBT), *VRT = (bf16_t*)(ws + OFF_VRT), *GR = (bf16_t*)(ws + OFF_GR),
               *QA = (bf16_t*)(ws + OFF_QA), *KA = (bf16_t*)(ws + OFF_KA), *VAT = (bf16_t*)(ws + OFF_VAT), *SR = (bf16_t*)(ws + OFF_SR), *SA = (bf16_t*)(ws + OFF_SA);
        const int rbase = u.pm * 256 + u.hsel * 128 + wr * 64 + fr;
        float rs[8];
#pragma unroll
        for (int i = 0; i < 8; ++i) rs[i] = ss[rbase + (i >> 2) * 128 + (i & 3) * 16];
        const bool ropeR = pn < 4, ropeA = (pn >= 8 && pn < 10) || (pn == 10 && wc < 2);
        f32x4 tn[4];
        if (ropeR || ropeA) { const int s0 = rbase & (SEQ - 1); const f32x4* tp0 = ropeR ? tabR + ((size_t)s0 * 64 + (p0 & 63)) / 2 : tabA + ((size_t)s0 * 32 + (p0 & 31)) / 2;
#pragma unroll
            for (int q = 0; q < 4; ++q) tn[q] = tp0[q]; }
#pragma unroll
        for (int ai = 0; ai < 2; ++ai)
#pragma unroll
            for (int m = 0; m < 4; ++m) {
                if (ai == 1 && u.half) continue;
                const int row = rbase + ai * 128 + m * 16;
                const float rstd = rsqrtf(rs[ai * 4 + m] * (1.f / 1024.f) + EPS);
                const int s = row & (SEQ - 1), b = row >> 12;
                f32x4 tc[4];
#pragma unroll
                for (int q = 0; q < 4; ++q) tc[q] = tn[q];
                if ((ropeR || ropeA) && (ai * 4 + m) < 7) { const int i1 = ai * 4 + m + 1; const int s1 = (rbase + (i1 >> 2) * 128 + (i1 & 3) * 16) & (SEQ - 1);
                    const f32x4* tp1 = ropeR ? tabR + ((size_t)s1 * 64 + (p0 & 63)) / 2 : tabA + ((size_t)s1 * 32 + (p0 & 31)) / 2;
#pragma unroll
                    for (int q = 0; q < 4; ++q) tn[q] = tp1[q]; }
                float lo[8], hi[8];
#pragma unroll
                for (int e = 0; e < 4; ++e) { lo[e] = acc[ai][0][m][0][e] * rstd; lo[4 + e] = acc[ai][0][m][1][e] * rstd; hi[e] = acc[ai][1][m][0][e] * rstd; hi[4 + e] = acc[ai][1][m][1][e] * rstd; }
                if (pn < 4) {
                    const int head = 2 * (pn & 1) + (p0 >> 6), j0 = p0 & 63;
                    float o1[8], o2[8];
#pragma unroll
                    for (int q = 0; q < 4; ++q) { const f32x4 cs = tc[q];
                        o1[2 * q] = lo[2 * q] * cs[0] - hi[2 * q] * cs[1]; o2[2 * q] = lo[2 * q] * cs[1] + hi[2 * q] * cs[0];
                        o1[2 * q + 1] = lo[2 * q + 1] * cs[2] - hi[2 * q + 1] * cs[3]; o2[2 * q + 1] = lo[2 * q + 1] * cs[3] + hi[2 * q + 1] * cs[2]; }
                    if (pn < 2) {
                        bf16_t* qp = QR + (size_t)row * 512 + head * 128 + j0;
                        *(u32x4*)qp = pack8(o1); *(u32x4*)(qp + 64) = pack8(o2);
                    } else {
                        const float ksc = 0.08838834764831845f;
#pragma unroll
                        for (int e = 0; e < 8; ++e) { o1[e] *= ksc; o2[e] *= ksc; }
                        bf16_t* kp = KR + (((size_t)(b * 4 + head) * 32 + (s >> 7)) * 128 + (s & 127)) * 128;
                        *(u32x4*)(kp + (((j0 >> 3) ^ (s & 15)) << 3)) = pack8(o1); *(u32x4*)(kp + ((((j0 >> 3) + 8) ^ (s & 15)) << 3)) = pack8(o2);
                        const f32x4 dd = dt[head * 128 + (s & 127)];
                        const size_t tb = (((size_t)(b * 4 + head) * 32 + (s >> 7)) * 128 + j0) * 128 + (s & 7);
                        const int tc = (s & 127) >> 3;
#pragma unroll
                        for (int e = 0; e < 8; ++e) { const int sw = ((tc ^ ((j0 + e) & 15)) << 3);
                            KFT[tb + (size_t)e * 128 + sw] = f2bf(o1[e] * dd[2]); KFT[tb + (size_t)(64 + e) * 128 + sw] = f2bf(o2[e] * dd[2]);
                            KBT[tb + (size_t)e * 128 + sw] = f2bf(o1[e] * dd[3]); KBT[tb + (size_t)(64 + e) * 128 + sw] = f2bf(o2[e] * dd[3]);
                        }
                    }
                } else if (pn < 6) {
                    const int h0 = 2 * (pn - 4);
                    const size_t tb = (((size_t)(b * 4 + h0) * 32 + (s >> 7)) * 128 + p0) * 128 + (s & 7);
                    const int tc = (s & 127) >> 3;
#pragma unroll
                    for (int e = 0; e < 8; ++e) { const int sw = ((tc ^ ((p0 + e) & 15)) << 3); VRT[tb + (size_t)e * 128 + sw] = f2bf(lo[e]); VRT[tb + (size_t)32 * 16384 + (size_t)e * 128 + sw] = f2bf(hi[e]); }
                } else if (pn < 8) {
#pragma unroll
                    for (int e = 0; e < 8; ++e) { lo[e] = lo[e] * sigm(lo[e]); hi[e] = hi[e] * sigm(hi[e]); }
                    bf16_t* gp = GR + (size_t)row * 512 + (pn - 6) * 256 + p0;
                    *(u32x4*)gp = pack8(lo); *(u32x4*)(gp + 128) = pack8(hi);
                } else if (pn < 10 || (pn == 10 && wc < 2)) {
                    const int j0 = p0 & 31;
                    float o1[8], o2[8];
                    const float sc = (pn < 10) ? 0.125f : 1.0f;
#pragma unroll
                    for (int q = 0; q < 4; ++q) { const f32x4 cs = tc[q];
                        o1[2 * q] = (lo[2 * q] * cs[0] - hi[2 * q] * cs[1]) * sc; o2[2 * q] = (lo[2 * q] * cs[1] + hi[2 * q] * cs[0]) * sc;
                        o1[2 * q + 1] = (lo[2 * q + 1] * cs[2] - hi[2 * q + 1] * cs[3]) * sc; o2[2 * q + 1] = (lo[2 * q + 1] * cs[3] + hi[2 * q + 1] * cs[2]) * sc; }
                    if (pn < 10) { bf16_t* dp = QA + (size_t)row * 512 + (4 * (pn - 8) + (p0 >> 5)) * 64 + j0; *(u32x4*)dp = pack8(o1); *(u32x4*)(dp + 32) = pack8(o2); }
                    else {
                        bf16_t* dp = KA + ((((size_t)(b * 2 + (p0 >> 5)) * 32 + (s >> 7)) * 128 + (s & 127)) << 6); const int sw = ((s & 127) >> 1) & 7;
                        *(u32x4*)(dp + (((j0 >> 3) ^ sw) << 3)) = pack8(o1); *(u32x4*)(dp + ((((j0 >> 3) + 4) ^ sw) << 3)) = pack8(o2); }
                } else if (pn == 10) {
                    const int d0 = p0 - 64;
                    const size_t tb = (((size_t)(b * 2) * 32 + (s >> 7)) * 64 + d0) * 128 + (s & 7);
                    const int tc = (s & 127) >> 3;
#pragma unroll
                    for (int e = 0; e < 8; ++e) { const int sw = ((tc ^ ((d0 + e) & 15)) << 3); VAT[tb + (size_t)e * 128 + sw] = f2bf(lo[e]); VAT[tb + (size_t)32 * 8192 + (size_t)e * 128 + sw] = f2bf(hi[e]); }
                } else {
#pragma unroll
                    for (int e = 0; e < 8; ++e) { lo[e] = sigm(lo[e]); hi[e] = sigm(hi[e]); }
                    unsigned char* gp = (ws + (pn < 15 ? OFF_SR : OFF_SA)) + (row * D + (pn < 15 ? pn - 11 : pn - 15) * 256 + p0);
                    u32x2 wl, wh;
                    wl.x = __builtin_amdgcn_cvt_pk_u8_f32(lo[3] * 255.f, 3, __builtin_amdgcn_cvt_pk_u8_f32(lo[2] * 255.f, 2, __builtin_amdgcn_cvt_pk_u8_f32(lo[1] * 255.f, 1, __builtin_amdgcn_cvt_pk_u8_f32(lo[0] * 255.f, 0, 0u))));
                    wl.y = __builtin_amdgcn_cvt_pk_u8_f32(lo[7] * 255.f, 3, __builtin_amdgcn_cvt_pk_u8_f32(lo[6] * 255.f, 2, __builtin_amdgcn_cvt_pk_u8_f32(lo[5] * 255.f, 1, __builtin_amdgcn_cvt_pk_u8_f32(lo[4] * 255.f, 0, 0u))));
                    wh.x = __builtin_amdgcn_cvt_pk_u8_f32(hi[3] * 255.f, 3, __builtin_amdgcn_cvt_pk_u8_f32(hi[2] * 255.f, 2, __builtin_amdgcn_cvt_pk_u8_f32(hi[1] * 255.f, 1, __builtin_amdgcn_cvt_pk_u8_f32(hi[0] * 255.f, 0, 0u))));
                    wh.y = __builtin_amdgcn_cvt_pk_u8_f32(hi[7] * 255.f, 3, __builtin_amdgcn_cvt_pk_u8_f32(hi[6] * 255.f, 2, __builtin_amdgcn_cvt_pk_u8_f32(hi[5] * 255.f, 1, __builtin_amdgcn_cvt_pk_u8_f32(hi[4] * 255.f, 0, 0u))));
                    *(u32x2*)gp = wl; *(u32x2*)(gp + 128) = wh;
                }
            }
    }
};

struct MapFfnIn { __device__ __forceinline__ int operator()(int n) const { const int r = n & 255, ffi = (n >> 8) * 128 + (r & 127); if (ffi >= FF) return -1; return r < 128 ? ffi : FF + ffi; } };
struct MapNat { __device__ __forceinline__ int operator()(int n) const { return n; } };
struct MapWin { __device__ __forceinline__ int operator()(int n) const {
    const int t = n >> 8, r = n & 255, rl = r & 127, hf = r >> 7;
    if (t < 2) return (2 * t + (rl >> 6)) * 128 + hf * 64 + (rl & 63);
    if (t < 4) return 512 + (2 * (t - 2) + (rl >> 6)) * 128 + hf * 64 + (rl & 63);
    if (t < 8) return 1024 + (t - 4) * 256 + r;
    if (t < 10) return 2048 + (4 * (t - 8) + (rl >> 5)) * 64 + hf * 32 + (rl & 31);
    if (t == 10) { if (rl < 64) return 2560 + (rl >> 5) * 64 + hf * 32 + (rl & 31); return 2688 + hf * 64 + (rl - 64); }
    return 2816 + (t - 11) * 256 + r;
} };

template <class Map>
__device__ __forceinline__ void tr_item(const float* W, int Ksrc, int Nsrc, bf16_t* WT, int Kdst, const float* gain, LAS float* scr, int kb, int nb, int lane, Map map) {
    const int k0 = 64 * kb, n0 = 32 * nb, sc = map(n0);
    const bool valid = (sc >= 0) && (k0 < Ksrc);
    float tv[32];
#pragma unroll
    for (int i = 0; i < 32; ++i) { const int kk = 2 * i + (lane >> 5); tv[i] = valid ? W[(size_t)(k0 + kk) * Nsrc + sc + (lane & 31)] : 0.f; }
#pragma unroll
    for (int i = 0; i < 32; ++i) { const int kk = 2 * i + (lane >> 5); scr[kk * 33 + (lane & 31)] = tv[i]; }
    asm volatile("s_waitcnt vmcnt(0) lgkmcnt(0)" ::: "memory");
    const int c = lane & 7;
    float gk[8];
#pragma unroll
    for (int e = 0; e < 8; ++e) gk[e] = (gain && valid) ? gain[k0 + 8 * c + e] : 1.f;
#pragma unroll
    for (int j = 0; j < 4; ++j) { const int n = (lane >> 3) + 8 * j; const LAS float* sp = scr + (8 * c) * 33 + n;
        float v[8];
#pragma unroll
        for (int e = 0; e < 8; ++e) v[e] = sp[e * 33] * gk[e];
        *(u32x4*)(WT + (size_t)(n0 + n) * Kdst + k0 + 8 * c) = pack8(v); }
    asm volatile("s_waitcnt lgkmcnt(0)" ::: "memory");
}

__device__ __forceinline__ void p0_prologue(const Params& P, LAS unsigned char* lds, int wid, int lane) {
    unsigned char* ws = P.ws;
    LAS float* scr = (LAS float*)(lds + wid * 16384);
    const int G = gridDim.x, gw = blockIdx.x * 8 + wid, NGW = G * 8, gt = blockIdx.x * 512 + threadIdx.x, NT = G * 512;
    constexpr int I_FI = 16 * (NFF2 / 32), I_FO = (FFP / 64) * 32, I_IN = 16 * (NIN / 32), I_RO = 8 * 32, I_OUT = 16 * 32;
    constexpr int NITEMS = 2 * I_FI + 2 * I_FO + I_IN + 2 * I_RO + I_OUT;
    for (int it = gw; it < NITEMS; it += NGW) {
        int r = it;
        if (r < I_FI) { tr_item(P.w1i, D, 2 * FF, (bf16_t*)(ws + OFF_W1T), D, P.g1, scr, r / (NFF2 / 32), r % (NFF2 / 32), lane, MapFfnIn()); continue; } r -= I_FI;
        if (r < I_FI) { tr_item(P.w2i, D, 2 * FF, (bf16_t*)(ws + OFF_W2T), D, P.g2, scr, r / (NFF2 / 32), r % (NFF2 / 32), lane, MapFfnIn()); continue; } r -= I_FI;
        if (r < I_FO) { tr_item(P.w1o, FF, D, (bf16_t*)(ws + OFF_W1O), FFP, nullptr, scr, r / 32, r % 32, lane, MapNat()); continue; } r -= I_FO;
        if (r < I_FO) { tr_item(P.w2o, FF, D, (bf16_t*)(ws + OFF_W2O), FFP, nullptr, scr, r / 32, r % 32, lane, MapNat()); continue; } r -= I_FO;
        if (r < I_IN) { tr_item(P.win, D, NIN, (bf16_t*)(ws + OFF_WIN), D, P.gmix, scr, r / (NIN / 32), r % (NIN / 32), lane, MapWin()); continue; } r -= I_IN;
        if (r < I_RO) { tr_item(P.wret, 512, D, (bf16_t*)(ws + OFF_WRET), 512, nullptr, scr, r / 32, r % 32, lane, MapNat()); continue; } r -= I_RO;
        if (r < I_RO) { tr_item(P.watt, 512, D, (bf16_t*)(ws + OFF_WATT), 512, nullptr, scr, r / 32, r % 32, lane, MapNat()); continue; } r -= I_RO;
        tr_item(P.wout, D, D, (bf16_t*)(ws + OFF_WOUT), D, nullptr, scr, r / 32, r % 32, lane, MapNat());
    }
    float* ss = (float*)(ws + OFF_SS);
    bf16_t* XB = (bf16_t*)(ws + OFF_XB);
    for (int row0 = gw; row0 < T; row0 += 4 * NGW) {
        f32x4 v[4][4];
#pragma unroll
        for (int r = 0; r < 4; ++r) { const f32x4* xr = (const f32x4*)(P.x + (size_t)(row0 + r * NGW) * D) + lane;
#pragma unroll
            for (int j = 0; j < 4; ++j) v[r][j] = xr[64 * j]; }
#pragma unroll
        for (int r = 0; r < 4; ++r) { const int row = row0 + r * NGW; float sq = 0.f;
#pragma unroll
            for (int j = 0; j < 4; ++j) sq += (v[r][j][0] * v[r][j][0] + v[r][j][1] * v[r][j][1]) + (v[r][j][2] * v[r][j][2] + v[r][j][3] * v[r][j][3]);
#pragma unroll
            for (int o = 1; o < 64; o <<= 1) sq += __shfl_xor(sq, o);
            u32x2* o8 = (u32x2*)(XB + (size_t)row * D) + lane;
#pragma unroll
            for (int j = 0; j < 4; ++j) { u32x2 w; w.x = cvt_pk_bf16(v[r][j][0], v[r][j][1]); w.y = cvt_pk_bf16(v[r][j][2], v[r][j][3]); o8[64 * j] = w; }
            if (lane == 0) ss[row] = sq; }
    }
    for (int i = gt; i < 3 * T; i += NT) ss[T + i] = 0.f;
    f32x2* tabR = (f32x2*)(ws + OFF_TABR); f32x2* tabA = (f32x2*)(ws + OFF_TABA);
    const double L2T = 13.287712379549449;
    const double INV2PI = 0.15915494309189535;
    for (int i = gt; i < SEQ * 64; i += NT) { const int s = i >> 6, j = i & 63; const float invf = (float)exp2(-(double)j * (1.0 / 64.0) * L2T);
        const float ang = (float)s * invf; double rev = (double)ang * INV2PI; rev -= rint(rev);
        tabR[i] = (f32x2){__builtin_amdgcn_cosf((float)rev), __builtin_amdgcn_sinf((float)rev)}; }
    for (int i = gt; i < SEQ * 32; i += NT) { const int s = i >> 5, j = i & 31; const float invf = (float)exp2(-(double)j * (1.0 / 32.0) * L2T);
        const float ang = (float)s * invf; double rev = (double)ang * INV2PI; rev -= rint(rev);
        tabA[i] = (f32x2){__builtin_amdgcn_cosf((float)rev), __builtin_amdgcn_sinf((float)rev)}; }
    { float* sm = (float*)(ws + OFF_SM);
      if (gt < 4) { sm[gt] = -expf(P.dfw[gt]); sm[4 + gt] = -expf(P.dbw[gt]); }
      if (gt < 8) sm[8 + gt] = P.sink[gt];
      if (gt < 512) sm[64 + gt] = P.gng[gt]; }
    if (gt < 512) { const int h = gt >> 7, i = gt & 127; const float lgf = -expf(P.dfw[h]), lgb = -expf(P.dbw[h]);
        ((f32x4*)(ws + OFF_DT))[gt] = (f32x4){expf(lgf * (float)(i + 1)), expf(lgb * (float)(128 - i)), expf(lgf * (float)(127 - i)), expf(lgb * (float)i)}; }
}

__device__ __forceinline__ void attn_unit(unsigned char* ws, LAS unsigned char* lds, int u, int wid, int lane) {
    asm volatile("" : "+v"(lane));
    const int blk = u & 31, bk = u >> 5, hk = bk & 1, b = bk >> 1, fr = lane & 15, g = lane >> 4;
    bf16_t* QA = (bf16_t*)(ws + OFF_QA);
    const char* srcK = (const char*)(ws + OFF_KA) + ((size_t)bk * 32 + (blk - 1)) * 16384;
    const char* srcV = (const char*)(ws + OFF_VAT) + ((size_t)bk * 32 + (blk - 1)) * 16384;
    __syncthreads();
#pragma unroll
    for (int j = 0; j < 6; ++j) { const int piece = j * 8 + wid, pbk = piece >> 4; const int gb = blk - 1 + pbk;
        if (gb >= 0 && gb < 32) { const size_t go = (size_t)piece * 1024 + lane * 16;
            __builtin_amdgcn_global_load_lds((const unsigned*)(srcK + go), (LAS unsigned*)(lds + piece * 1024), 16, 0, 0);
            __builtin_amdgcn_global_load_lds((const unsigned*)(srcV + go), (LAS unsigned*)(lds + 49152 + piece * 1024), 16, 0, 0); } }
    const int q0 = blk * 128 + wid * 16, n = q0 + fr;
    asm volatile("s_waitcnt vmcnt(0)" ::: "memory");
    __syncthreads();
    const LAS unsigned char* krow = lds + fr * 128;
    const LAS unsigned char* vrow = lds + 49152 + fr * 256 + 8 * (g & 1);
#pragma unroll 1
    for (int hp = 0; hp < 2; ++hp) {
        const int head0 = hk * 4 + 2 * hp;
        bf16_t* qp = QA + ((size_t)(b * SEQ + q0 + fr)) * 512 + head0 * 64;
        bf16x8 bq[2][2];
#pragma unroll
        for (int hh = 0; hh < 2; ++hh) { bq[hh][0] = *(const bf16x8*)(qp + hh * 64 + 8 * g); bq[hh][1] = *(const bf16x8*)(qp + hh * 64 + 32 + 8 * g); }
        float m_run[2], l_run[2];
        f32x4 o[2][4];
#pragma unroll
        for (int hh = 0; hh < 2; ++hh) { m_run[hh] = ((const float*)(ws + OFF_SM))[8 + head0 + hh]; l_run[hh] = (g == 0) ? 1.f : 0.f;
#pragma unroll
            for (int rb = 0; rb < 4; ++rb) o[hh][rb] = (f32x4){0.f, 0.f, 0.f, 0.f}; }
#pragma unroll 1
        for (int gq = 0; gq < 3; ++gq) {
            const int kl0 = 16 * wid + 96 * gq;
            const int key0 = q0 - 128 + 96 * gq;
            bf16x8 ka[6][2]; bf16x4 vv[3][4][2]; bool inb[6];
#pragma unroll
            for (int bl = 0; bl < 6; ++bl) { const int kl = kl0 + 16 * bl, kp0 = key0 + 16 * bl; inb[bl] = (kp0 >= 0) && (kp0 < SEQ);
                const LAS unsigned char* kp = krow + (kl >> 7) * 16384 + (kl & 127) * 128;
                ka[bl][0] = *(const LAS bf16x8*)(kp + ((g ^ (fr >> 1)) << 4)); ka[bl][1] = *(const LAS bf16x8*)(kp + (((4 + g) ^ (fr >> 1)) << 4)); }
#pragma unroll
            for (int t = 0; t < 3; ++t)
#pragma unroll
                for (int hf = 0; hf < 2; ++hf) { const int kl = kl0 + 16 * (2 * t + hf); const int vb = inb[2 * t + hf] ? (kl >> 7) : 1;
                    const LAS unsigned char* vp = vrow + vb * 16384 + (((((kl & 127) >> 3) + (g >> 1)) ^ fr) << 4);
#pragma unroll
                    for (int rb = 0; rb < 4; ++rb) vv[t][rb][hf] = *(const LAS bf16x4*)(vp + rb * 4096); }
#pragma unroll
            for (int hh = 0; hh < 2; ++hh) {
                float p[6][4]; float mx = -INFINITY;
#pragma unroll
                for (int bl = 0; bl < 6; ++bl) {
                    f32x4 sacc = (f32x4){0.f, 0.f, 0.f, 0.f};
                    sacc = MFMA16(ka[bl][0], bq[hh][0], sacc); sacc = MFMA16(ka[bl][1], bq[hh][1], sacc);
#pragma unroll
                    for (int i = 0; i < 4; ++i) { const int dd = n - (key0 + 16 * bl + 4 * g + i); const bool ok = inb[bl] && dd <= 128 && dd >= -128; p[bl][i] = ok ? sacc[i] : -INFINITY; mx = fmaxf(mx, p[bl][i]); }
                }
                mx = fmaxf(mx, __shfl_xor(mx, 16)); mx = fmaxf(mx, __shfl_xor(mx, 32));
                const float m_new = fmaxf(m_run[hh], mx), alpha = __expf(m_run[hh] - m_new);
                float ps = 0.f;
#pragma unroll
                for (int bl = 0; bl < 6; ++bl)
#pragma unroll
                    for (int i = 0; i < 4; ++i) { p[bl][i] = __expf(p[bl][i] - m_new); ps += p[bl][i]; }
                l_run[hh] = l_run[hh] * alpha + ps; m_run[hh] = m_new;
#pragma unroll
                for (int rb = 0; rb < 4; ++rb) o[hh][rb] = o[hh][rb] * alpha;
#pragma unroll
                for (int t = 0; t < 3; ++t) {
                    u32x4 pw; pw.x = cvt_pk_bf16(p[2 * t][0], p[2 * t][1]); pw.y = cvt_pk_bf16(p[2 * t][2], p[2 * t][3]); pw.z = cvt_pk_bf16(p[2 * t + 1][0], p[2 * t + 1][1]); pw.w = cvt_pk_bf16(p[2 * t + 1][2], p[2 * t + 1][3]);
                    const bf16x8 pb = __builtin_bit_cast(bf16x8, pw);
#pragma unroll
                    for (int rb = 0; rb < 4; ++rb) { const bf16x8 va = __builtin_shufflevector(vv[t][rb][0], vv[t][rb][1], 0, 1, 2, 3, 4, 5, 6, 7); o[hh][rb] = MFMA16(va, pb, o[hh][rb]); }
                }
            }
        }
#pragma unroll
        for (int hh = 0; hh < 2; ++hh) {
            float l = l_run[hh]; l += __shfl_xor(l, 16); l += __shfl_xor(l, 32);
            const float inv = 1.f / l;
#pragma unroll
            for (int rb = 0; rb < 4; ++rb) { u32x2 w; w.x = cvt_pk_bf16(o[hh][rb][0] * inv, o[hh][rb][1] * inv); w.y = cvt_pk_bf16(o[hh][rb][2] * inv, o[hh][rb][3] * inv);
                *(u32x2*)(qp + hh * 64 + 16 * rb + 4 * g) = w; }
        }
    }
}

__device__ __forceinline__ void r12_unit(unsigned char* ws, bf16_t* kvs, LAS unsigned char* lds, int u, int wid, int lane) {
    asm volatile("" : "+v"(lane));
    const int slice = u & 3, dir = (u >> 2) & 1, bh = u >> 3, h = bh & 3, fr = lane & 15, g = lane >> 4;
    const float gc = expf(128.f * ((const float*)(ws + OFF_SM))[4 * dir + h]);
    const char* KT = (const char*)(ws + (dir ? OFF_KBT : OFF_KFT)) + (size_t)bh * 32 * 32768 + lane * 16;
    const char* VT = (const char*)(ws + OFF_VRT) + (size_t)bh * 32 * 32768 + slice * 8192 + wid * 1024 + lane * 16;
    bf16_t* SO = kvs + ((size_t)bh * 64 + dir) * 16384 + (32 * slice + fr) * 128 + (((2 * wid + (g >> 1)) ^ fr) << 3) + 4 * (g & 1);
    const int c0 = dir ? 31 : 0, cs = dir ? -1 : 1;
    constexpr int STG = 40960;
#define R12_DMA(i) do { const int _c = c0 + (i) * cs; LAS unsigned char* _st = lds + ((i) % 3) * STG; \
        _Pragma("unroll") for (int _j = 0; _j < 4; ++_j) __builtin_amdgcn_global_load_lds((const unsigned*)(KT + (size_t)_c * 32768 + (_j * 8 + wid) * 1024), (LAS unsigned*)(_st + (_j * 8 + wid) * 1024), 16, 0, 0); \
        __builtin_amdgcn_global_load_lds((const unsigned*)(VT + (size_t)_c * 32768), (LAS unsigned*)(_st + 32768 + wid * 1024), 16, 0, 0); } while (0)
    f32x4 S[2] = {(f32x4){0.f, 0.f, 0.f, 0.f}, (f32x4){0.f, 0.f, 0.f, 0.f}};
    asm volatile("s_waitcnt vmcnt(0)" ::: "memory");
    __builtin_amdgcn_s_barrier();
    R12_DMA(0); R12_DMA(1);
    const unsigned aoff = (16 * wid + fr) * 256, boff = 32768 + fr * 256;
#pragma unroll 1
    for (int i = 0; i < 32; ++i) {
        if (i + 2 < 32) R12_DMA(i + 2);
        if (i == 0) asm volatile("s_waitcnt vmcnt(10)" ::: "memory");
        else if (i == 1) asm volatile("s_waitcnt vmcnt(12)" ::: "memory");
        else if (i < 30) asm volatile("s_waitcnt vmcnt(14)" ::: "memory");
        else asm volatile("s_waitcnt vmcnt(4)" ::: "memory");
        __builtin_amdgcn_s_barrier();
        asm volatile("" ::: "memory");
        const LAS unsigned char* st = lds + (i % 3) * STG;
        const int c = c0 + i * cs;
#pragma unroll
        for (int cb = 0; cb < 2; ++cb) { u32x2 w; w.x = cvt_pk_bf16(S[cb][0], S[cb][1]); w.y = cvt_pk_bf16(S[cb][2], S[cb][3]); *(u32x2*)(SO + (size_t)c * 32768 + cb * 2048) = w; }
        f32x4 kv0 = (f32x4){0.f, 0.f, 0.f, 0.f}, kv1 = kv0;
#pragma unroll
        for (int ks = 0; ks < 4; ++ks) { const int sw = (((4 * ks + g) ^ fr) << 4);
            const bf16x8 a = *(const LAS bf16x8*)(st + aoff + sw), b0 = *(const LAS bf16x8*)(st + boff + sw), b1 = *(const LAS bf16x8*)(st + boff + 4096 + sw);
            kv0 = MFMA16(a, b0, kv0); kv1 = MFMA16(a, b1, kv1); }
        S[0] = S[0] * gc + kv0; S[1] = S[1] * gc + kv1;
        asm volatile("s_waitcnt lgkmcnt(0)" ::: "memory");
        __builtin_amdgcn_s_barrier();
        asm volatile("" ::: "memory");
    }
#undef R12_DMA
    asm volatile("s_waitcnt vmcnt(0)" ::: "memory");
}

__device__ __forceinline__ void r3_unit(unsigned char* ws, const bf16_t* kvs, LAS unsigned char* lds, int u, int wid, int lane) {
    asm volatile("" : "+v"(lane));
    const int c = u & 31, bh = u >> 5, h = bh & 3, b = bh >> 2, fr = lane & 15, g = lane >> 4;
    bf16_t* QR = (bf16_t*)(ws + OFF_QR); const bf16_t* GR = (const bf16_t*)(ws + OFF_GR);
    const char* srcK = (const char*)(ws + OFF_KR) + ((size_t)bh * 32 + c) * 32768;
    const char* srcV = (const char*)(ws + OFF_VRT) + ((size_t)bh * 32 + c) * 32768;
    const char* srcS = (const char*)kvs + ((size_t)bh * 32 + c) * 65536;
    __syncthreads();
#pragma unroll
    for (int j = 0; j < 4; ++j) { const int piece = j * 8 + wid; const size_t go = (size_t)piece * 1024 + lane * 16;
        __builtin_amdgcn_global_load_lds((const unsigned*)(srcK + go), (LAS unsigned*)(lds + piece * 1024), 16, 0, 0);
        __builtin_amdgcn_global_load_lds((const unsigned*)(srcV + go), (LAS unsigned*)(lds + 32768 + piece * 1024), 16, 0, 0);
        __builtin_amdgcn_global_load_lds((const unsigned*)(srcS + go), (LAS unsigned*)(lds + 65536 + piece * 1024), 16, 0, 0);
        __builtin_amdgcn_global_load_lds((const unsigned*)(srcS + 32768 + go), (LAS unsigned*)(lds + 98304 + piece * 1024), 16, 0, 0); }
    const int nq = 16 * wid + fr;
    const size_t tokq = (size_t)b * SEQ + c * 128 + nq;
    bf16_t* qp = QR + tokq * 512 + h * 128;
    bf16x8 bq[4];
#pragma unroll
    for (int ks = 0; ks < 4; ++ks) bq[ks] = *(const bf16x8*)(qp + 32 * ks + 8 * g);
    const float lgf = ((const float*)(ws + OFF_SM))[h], lgb = ((const float*)(ws + OFF_SM))[4 + h];
    const f32x4 dq = ((const f32x4*)(ws + OFF_DT))[h * 128 + nq];
    asm volatile("s_waitcnt vmcnt(0)" ::: "memory");
    __syncthreads();
    const LAS unsigned char* rowp = lds + fr * 256;
    bf16x8 pb[4];
#pragma unroll
    for (int kt = 0; kt < 4; ++kt) {
        float pv[8];
#pragma unroll
        for (int hf = 0; hf < 2; ++hf) {
            const int kb = 2 * kt + hf;
            f32x4 sacc = (f32x4){0.f, 0.f, 0.f, 0.f};
#pragma unroll
            for (int ks = 0; ks < 4; ++ks) { const bf16x8 a = *(const LAS bf16x8*)(rowp + kb * 4096 + (((4 * ks + g) ^ fr) << 4)); sacc = MFMA16(a, bq[ks], sacc); }
#pragma unroll
            for (int i = 0; i < 4; ++i) { const int dd = nq - (16 * kb + 4 * g + i); const float dec = dd >= 0 ? __expf(lgf * (float)dd) : __expf(lgb * (float)(-dd)); pv[4 * hf + i] = sacc[i] * dec; }
        }
        pb[kt] = __builtin_bit_cast(bf16x8, pack8(pv));
        __builtin_amdgcn_sched_barrier(0);
    }
    f32x4 y[8];
    float sum = 0.f;
#pragma unroll
    for (int rb = 0; rb < 8; ++rb) {
        f32x4 ya = (f32x4){0.f, 0.f, 0.f, 0.f}, cf = ya, cbk = ya;
#pragma unroll
        for (int kt = 0; kt < 4; ++kt) {
            const bf16x4 v0 = *(const LAS bf16x4*)(rowp + 32768 + rb * 4096 + (((4 * kt + (g >> 1)) ^ fr) << 4) + 8 * (g & 1));
            const bf16x4 v1 = *(const LAS bf16x4*)(rowp + 32768 + rb * 4096 + (((4 * kt + 2 + (g >> 1)) ^ fr) << 4) + 8 * (g & 1));
            const bf16x8 va = __builtin_shufflevector(v0, v1, 0, 1, 2, 3, 4, 5, 6, 7); ya = MFMA16(va, pb[kt], ya); }
#pragma unroll
        for (int ks = 0; ks < 4; ++ks) { const int so = rb * 4096 + (((4 * ks + g) ^ fr) << 4);
            const bf16x8 af = *(const LAS bf16x8*)(rowp + 65536 + so), ab = *(const LAS bf16x8*)(rowp + 98304 + so);
            cf = MFMA16(af, bq[ks], cf); cbk = MFMA16(ab, bq[ks], cbk); }
        y[rb] = ya + cf * dq[0] + cbk * dq[1];
        sum += (y[rb][0] + y[rb][1]) + (y[rb][2] + y[rb][3]);
        __builtin_amdgcn_sched_barrier(0);
    }
    sum += __shfl_xor(sum, 16); sum += __shfl_xor(sum, 32);
    const float mu = sum * (1.f / 128.f);
    float var = 0.f;
#pragma unroll
    for (int rb = 0; rb < 8; ++rb) { y[rb] = y[rb] - mu; var += (y[rb][0] * y[rb][0] + y[rb][1] * y[rb][1]) + (y[rb][2] * y[rb][2] + y[rb][3] * y[rb][3]); }
    var += __shfl_xor(var, 16); var += __shfl_xor(var, 32);
    const float rstd = rsqrtf(var * (1.f / 128.f) + EPS);
    const bf16_t* gp = GR + tokq * 512 + h * 128 + 4 * g;
    const float* gn = (const float*)(ws + OFF_SM) + 64 + h * 128 + 4 * g;
#pragma unroll
    for (int rb = 0; rb < 8; ++rb) {
        const u32x2 gw = *(const u32x2*)(gp + 16 * rb); const f32x4 gg = *(const f32x4*)(gn + 16 * rb);
        const float v0 = y[rb][0] * rstd * gg[0] * bflo(gw.x), v1 = y[rb][1] * rstd * gg[1] * bfhi(gw.x), v2 = y[rb][2] * rstd * gg[2] * bflo(gw.y), v3 = y[rb][3] * rstd * gg[3] * bfhi(gw.y);
        u32x2 w; w.x = cvt_pk_bf16(v0, v1); w.y = cvt_pk_bf16(v2, v3);
        *(u32x2*)(qp + 16 * rb + 4 * g) = w;
    }
}


#define XB_TMO      128
#define XB_XCNT(j)  (256  + 64 * (j))
#define XB_XSUB(j)  (1280 + 64 * (j))
#define XB_XGEN(j)  (2304 + 64 * (j))
#define XB_TOP      3328
#define XB_TOPGEN   3392
#define XCD_BAR_WORDS 3456
#define XB_SPIN_CAP (1u << 22)
__device__ __forceinline__ unsigned xb_ld(unsigned* p)              { return __hip_atomic_load(p, __ATOMIC_RELAXED, __HIP_MEMORY_SCOPE_AGENT); }
__device__ __forceinline__ unsigned xb_add(unsigned* p, unsigned v) { return __hip_atomic_fetch_add(p, v, __ATOMIC_RELAXED, __HIP_MEMORY_SCOPE_AGENT); }
__device__ __forceinline__ unsigned xb_xcc_id() { return (unsigned)__builtin_amdgcn_s_getreg((3 << 11) | 20) & 0xFu; }
#define XB_SPIN(cond, bar) do { unsigned _sp = 0; while (cond) { __builtin_amdgcn_s_sleep(1); \
    if ((++_sp & 255u) == 0u) { if (xb_ld(&(bar)[XB_TMO])) break; if (_sp > XB_SPIN_CAP) { atomicAdd(&(bar)[XB_TMO], 1u); break; } } } } while (0)
struct XcdBarrier { unsigned* bar; unsigned x; volatile LAS unsigned* st; };
__device__ __forceinline__ XcdBarrier xcd_barrier_post(unsigned* bar, volatile LAS unsigned* st) {
    XcdBarrier b; b.bar = bar; b.x = xb_xcc_id(); b.st = st;
    if (threadIdx.x == 0) (void)xb_add(&bar[XB_XCNT(b.x)], 1u);
    return b;
}
__device__ __forceinline__ void xcd_barrier_complete(unsigned* bar, unsigned x, unsigned& nloc, unsigned& nx) {
    const unsigned G = gridDim.x * gridDim.y * gridDim.z;
    unsigned sum, cnt, mine, sp = 0u;
    for (;;) {
        sum = 0u; cnt = 0u; mine = 0u;
#pragma unroll
        for (unsigned j = 0; j < 16; ++j) { const unsigned c = xb_ld(&bar[XB_XCNT(j)]); sum += c; cnt += (c > 0u) ? 1u : 0u; mine = (j == x) ? c : mine; }
        if (sum == G) break;
        __builtin_amdgcn_s_sleep(1);
        if ((++sp & 255u) == 0u) { if (xb_ld(&bar[XB_TMO])) break; if (sp > XB_SPIN_CAP) { atomicAdd(&bar[XB_TMO], 1u); break; } }
    }
    nloc = mine > 0u ? mine : 1u; nx = cnt > 0u ? cnt : 1u;
}
__device__ __forceinline__ void xcd_barrier(const XcdBarrier& b) {
    asm volatile("s_waitcnt vmcnt(0)" ::: "memory");
    __syncthreads();
    if (threadIdx.x == 0) {
        unsigned* bar = b.bar;
        __builtin_amdgcn_s_waitcnt(0);
        unsigned nloc = b.st[0], nx = b.st[1];
        if (nloc == 0u) { xcd_barrier_complete(bar, b.x, nloc, nx); b.st[0] = nloc; b.st[1] = nx; }
        const unsigned old = xb_add(&bar[XB_XSUB(b.x)], 1u);
        const unsigned gen = old / nloc;
        if (old + 1u == (gen + 1u) * nloc) {
            __builtin_amdgcn_fence(__ATOMIC_RELEASE, "agent");
            asm volatile("s_waitcnt vmcnt(0)" ::: "memory");
            const unsigned og = xb_add(&bar[XB_TOP], 1u);
            const unsigned tg = og / nx;
            if (og + 1u == (tg + 1u) * nx) xb_add(&bar[XB_TOPGEN], 1u);
            else XB_SPIN(xb_ld(&bar[XB_TOPGEN]) == tg, bar);
            __builtin_amdgcn_fence(__ATOMIC_ACQUIRE, "agent");
            xb_add(&bar[XB_XGEN(b.x)], 1u);
            asm volatile("s_waitcnt vmcnt(0)" ::: "memory");
        } else {
            XB_SPIN(xb_ld(&bar[XB_XGEN(b.x)]) == gen, bar);
            __builtin_amdgcn_fence(__ATOMIC_ACQUIRE, "agent");
            asm volatile("s_waitcnt vmcnt(0)" ::: "memory");
        }
    }
    __syncthreads();
}

__global__ void __launch_bounds__(512, 2) fwd_megakernel(Params P) {
    extern __shared__ __attribute__((aligned(16))) unsigned char lds_raw[];
    LAS unsigned char* lds = (LAS unsigned char*)lds_raw;
    cg::grid_group grid = cg::this_grid();
    const int tid = threadIdx.x, G = gridDim.x;
#define LANE_ ((int)(threadIdx.x & 63))
#define WID_ (__builtin_amdgcn_readfirstlane((int)(threadIdx.x >> 6)))
    unsigned char* ws = P.ws;
    float* ss = (float*)(ws + OFF_SS);
    bf16_t* XB = (bf16_t*)(ws + OFF_XB); bf16_t* H = (bf16_t*)(ws + OFF_BIG);
    pg8::StaticOrder S;

#define GSYNC() do { asm volatile("s_waitcnt vmcnt(0) lgkmcnt(0)" ::: "memory"); __syncthreads(); grid.sync(); \
        __builtin_amdgcn_fence(__ATOMIC_ACQUIRE, "agent"); asm volatile("s_waitcnt vmcnt(0)" ::: "memory"); __syncthreads(); } while (0)
    volatile LAS unsigned* bst = (volatile LAS unsigned*)(lds + 131072);
    if (tid < 4) bst[tid] = 0u;
    __syncthreads();
    XcdBarrier xbar = xcd_barrier_post((unsigned*)(ws + OFF_BARW), bst);
    if (P.ws == nullptr) GSYNC();
#undef GSYNC
#define GSYNC() xcd_barrier(xbar)
    p0_prologue(P, lds, WID_, LANE_);
    GSYNC();
    { pg8::Gemm g{XB, (const bf16_t*)(ws + OFF_W1T), T, NFF2, D}; S.init(T, NFF2, G, blockIdx.x); EpiSwiglu E{ws, 0}; pg8::gemm_phase(lds, g, S, E); }
    GSYNC();
    { pg8::Gemm g{H, (const bf16_t*)(ws + OFF_W1O), T, D, FFP}; S.init(T, D, G, blockIdx.x); EpiResid<false> E{nullptr, ws, 1, 0.5f}; pg8::gemm_phase(lds, g, S, E); }
    GSYNC();
    { pg8::Gemm g{XB, (const bf16_t*)(ws + OFF_WIN), T, NIN, D}; pg8::TailSplitOrder TS; TS.S.init(T, NIN, G, blockIdx.x);
      EpiProj E{ws};
      pg8::gemm_phase(lds, g, TS, E); }
    GSYNC();
    for (int u = blockIdx.x; u < 768; u += G) { if (u < 512) attn_unit(ws, lds, u, WID_, LANE_); else r12_unit(ws, (bf16_t*)P.out, lds, u - 512, WID_, LANE_); }
    asm volatile("s_waitcnt vmcnt(0)" ::: "memory"); __syncthreads();
    GSYNC();
    for (int u = blockIdx.x; u < 1024; u += G) r3_unit(ws, (const bf16_t*)P.out, lds, u, WID_, LANE_);
    asm volatile("s_waitcnt vmcnt(0)" ::: "memory"); __syncthreads();
    GSYNC();
    { S.init(T, D, G, blockIdx.x);
      { pg8::Gemm g{(const bf16_t*)(ws + OFF_QR), (const bf16_t*)(ws + OFF_WRET), T, D, 512}; EpiGate<false> E{ws}; pg8::gemm_phase(lds, g, S, E); }
      { pg8::Gemm g{(const bf16_t*)(ws + OFF_QA), (const bf16_t*)(ws + OFF_WATT), T, D, 512}; EpiGate<true> E{ws}; pg8::gemm_phase(lds, g, S, E); } }
    GSYNC();
    { pg8::Gemm g{(const bf16_t*)(ws + OFF_MG), (const bf16_t*)(ws + OFF_WOUT), T, D, D}; S.init(T, D, G, blockIdx.x); EpiResid<false> E{nullptr, ws, 2, 1.0f}; pg8::gemm_phase(lds, g, S, E); }
    GSYNC();
    { pg8::Gemm g{XB, (const bf16_t*)(ws + OFF_W2T), T, NFF2, D}; S.init(T, NFF2, G, blockIdx.x); EpiSwiglu E{ws, 2}; pg8::gemm_phase(lds, g, S, E); }
    GSYNC();
    { pg8::Gemm g{H, (const bf16_t*)(ws + OFF_W2O), T, D, FFP}; S.init(T, D, G, blockIdx.x); EpiResid<false> E{nullptr, ws, 3, 0.5f}; pg8::gemm_phase(lds, g, S, E); }
    GSYNC();
    int lane9 = threadIdx.x & 63; asm volatile("" : "+v"(lane9));
    {
        const f32x4* gf = (const f32x4*)P.gfin + lane9;
        for (int row0 = blockIdx.x * 8 + WID_; row0 < T; row0 += G * 32) {
            u32x2 w[4][4]; float rs4[4];
#pragma unroll
            for (int r = 0; r < 4; ++r) { const int row = row0 + r * G * 8; rs4[r] = ss[3 * T + row]; const u32x2* xr = (const u32x2*)(XB + (size_t)row * D) + lane9;
#pragma unroll
                for (int j = 0; j < 4; ++j) w[r][j] = xr[64 * j]; }
            f32x4 gg[4];
#pragma unroll
            for (int j = 0; j < 4; ++j) gg[j] = gf[64 * j];
#pragma unroll
            for (int r = 0; r < 4; ++r) { const int row = row0 + r * G * 8; const float rstd = rsqrtf(rs4[r] * (1.f / 1024.f) + EPS); f32x4* o = (f32x4*)(P.out + (size_t)row * D) + lane9;
#pragma unroll
                for (int j = 0; j < 4; ++j) o[64 * j] = (f32x4){bflo(w[r][j].x), bfhi(w[r][j].x), bflo(w[r][j].y), bfhi(w[r][j].y)} * rstd * gg[j]; }
        }
    }
}

extern "C" void kernel_launch(void* const* d_in, const int* in_sizes, int n_in, void* d_out, int out_size, void* d_ws, size_t ws_size, hipStream_t stream) {
    constexpr int LDS_BYTES = pg8::STAGE_BYTES + 256;
    static int grid = 0;
    if (grid == 0) {
        if (n_in != 17 || in_sizes[0] != T * D || out_size != T * D || ws_size < WS_END) { fprintf(stderr, "kernel_launch: unexpected shapes (n_in %d, in0 %d, out %d, ws %zu < %zu)\n", n_in, n_in > 0 ? in_sizes[0] : -1, out_size, ws_size, (size_t)WS_END); grid = -1; return; }
        int dev = 0, cus = 0, per_cu = 0;
        (void)hipGetDevice(&dev);
        (void)hipDeviceGetAttribute(&cus, hipDeviceAttributeMultiprocessorCount, dev);
        if (hipFuncSetAttribute((const void*)fwd_megakernel, hipFuncAttributeMaxDynamicSharedMemorySize, LDS_BYTES) != hipSuccess) { fprintf(stderr, "kernel_launch: hipFuncSetAttribute failed\n"); grid = -1; return; }
        if (hipOccupancyMaxActiveBlocksPerMultiprocessor(&per_cu, (const void*)fwd_megakernel, 512, LDS_BYTES) != hipSuccess || per_cu < 1) { fprintf(stderr, "kernel_launch: occupancy query failed (%d)\n", per_cu); (void)hipGetLastError(); per_cu = 1; }
        grid = cus * per_cu;
        if (grid > 2048) grid = 2048;
    }
    if (grid < 0) return;
    if (hipMemsetAsync((char*)d_ws + OFF_BARW, 0, 16384, stream) != hipSuccess) { fprintf(stderr, "kernel_launch: memset of the barrier words failed\n"); return; }
    Params p{};
    p.x = (const float*)d_in[0]; p.g1 = (const float*)d_in[1]; p.w1i = (const float*)d_in[2]; p.w1o = (const float*)d_in[3]; p.gmix = (const float*)d_in[4]; p.win = (const float*)d_in[5];
    p.dfw = (const float*)d_in[6]; p.dbw = (const float*)d_in[7]; p.gng = (const float*)d_in[8]; p.wret = (const float*)d_in[9]; p.sink = (const float*)d_in[10]; p.watt = (const float*)d_in[11];
    p.wout = (const float*)d_in[12]; p.g2 = (const float*)d_in[13]; p.w2i = (const float*)d_in[14]; p.w2o = (const float*)d_in[15]; p.gfin = (const float*)d_in[16];
    p.out = (float*)d_out; p.ws = (unsigned char*)d_ws;
    void* args[] = {&p};
    hipError_t e = hipLaunchCooperativeKernel((const void*)fwd_megakernel, dim3(grid), dim3(512), args, LDS_BYTES, stream);
    if (e != hipSuccess) fprintf(stderr, "cooperative launch failed: %s (grid %d)\n", hipGetErrorString(e), grid);
}
```

```cpp
#include <hip/hip_runtime.h>
#include <hip/hip_cooperative_groups.h>
#include <cstdio>
#include <cstdint>
namespace cg = cooperative_groups;

#define LAS __attribute__((address_space(3)))
typedef unsigned short bf16_t;
typedef short bf16x8 __attribute__((ext_vector_type(8)));
typedef short bf16x4 __attribute__((ext_vector_type(4)));
typedef float f32x4 __attribute__((ext_vector_type(4)));
typedef float f32x2 __attribute__((ext_vector_type(2)));
typedef unsigned u32x4 __attribute__((ext_vector_type(4)));
typedef unsigned u32x2 __attribute__((ext_vector_type(2)));

constexpr int T = 32768, D = 1024, FF = 2752, FFP = 2816, NFF2 = 5632, NIN = 4864, SEQ = 4096;
constexpr float EPS = 1e-6f;

constexpr size_t MiB = 1u << 20;
constexpr size_t OFF_W1T = 0;
constexpr size_t OFF_W2T = 11 * MiB;
constexpr size_t OFF_W1O = 22 * MiB;
constexpr size_t OFF_W2O = OFF_W1O + 5767168;
constexpr size_t OFF_WIN = 33 * MiB;
constexpr size_t OFF_WRET = OFF_WIN + 9961472;
constexpr size_t OFF_WATT = OFF_WRET + 1 * MiB;
constexpr size_t OFF_WOUT = OFF_WATT + 1 * MiB;
constexpr size_t OFF_TABR = OFF_WOUT + 2 * MiB;
constexpr size_t OFF_TABA = OFF_TABR + 2 * MiB;
constexpr size_t OFF_DT = OFF_TABA + 1 * MiB;
constexpr size_t OFF_SM = OFF_DT + 16384;
constexpr size_t OFF_SS = OFF_DT + 65536;
constexpr size_t OFF_XB = 51 * MiB;
constexpr size_t OFF_BIG = 115 * MiB;
constexpr size_t OFF_QR = OFF_BIG;
constexpr size_t OFF_KR = OFF_QR + 32 * MiB;
constexpr size_t OFF_KFT = OFF_KR + 32 * MiB;
constexpr size_t OFF_KBT = OFF_KFT + 32 * MiB;
constexpr size_t OFF_VRT = OFF_KBT + 32 * MiB;
constexpr size_t OFF_GR = OFF_VRT + 32 * MiB;
constexpr size_t OFF_QA = OFF_GR + 32 * MiB;
constexpr size_t OFF_KA = OFF_QA + 32 * MiB;
constexpr size_t OFF_VAT = OFF_KA + 8 * MiB;
constexpr size_t OFF_SR = OFF_VAT + 8 * MiB;
constexpr size_t OFF_SA = OFF_SR + 64 * MiB;
constexpr size_t OFF_MG = OFF_KR;
constexpr size_t OFF_BARW = OFF_SA + 64 * MiB;
constexpr size_t WS_END = OFF_BARW + 16384;
static_assert(OFF_SS + 4 * T * 4 <= OFF_XB, "ws map");
static_assert(OFF_BIG + (size_t)T * FFP * 2 <= WS_END, "ws map H");

struct Params {
    const float* x; const float* g1; const float* w1i; const float* w1o; const float* gmix; const float* win;
    const float* dfw; const float* dbw; const float* gng; const float* wret; const float* sink; const float* watt;
    const float* wout; const float* g2; const float* w2i; const float* w2o; const float* gfin;
    float* out; unsigned char* ws;
};

typedef __bf16 bf16v2_t __attribute__((ext_vector_type(2)));
__device__ __forceinline__ unsigned cvt_pk_bf16(float lo, float hi) { const f32x2 v = {lo, hi}; const bf16v2_t r = __builtin_convertvector(v, bf16v2_t); return __builtin_bit_cast(unsigned, r); }
__device__ __forceinline__ float bf2f(unsigned short b) { return __uint_as_float(((unsigned)b) << 16); }
__device__ __forceinline__ float bflo(unsigned w) { return __uint_as_float(w << 16); }
__device__ __forceinline__ float bfhi(unsigned w) { return __uint_as_float(w & 0xffff0000u); }
__device__ __forceinline__ unsigned short f2bf(float f) { unsigned u = __float_as_uint(f); return (unsigned short)((u + 0x7fffu + ((u >> 16) & 1u)) >> 16); }
__device__ __forceinline__ float sigm(float v) { return __builtin_amdgcn_rcpf(1.f + __expf(-v)); }
__device__ __forceinline__ u32x4 pack8(const float* v) { u32x4 w; w.x = cvt_pk_bf16(v[0], v[1]); w.y = cvt_pk_bf16(v[2], v[3]); w.z = cvt_pk_bf16(v[4], v[5]); w.w = cvt_pk_bf16(v[6], v[7]); return w; }
#define MFMA16(a, b, c) __builtin_amdgcn_mfma_f32_16x16x32_bf16((a), (b), (c), 0, 0, 0)

namespace pg8 {
constexpr int BM = 256, BK = 64, HALF = 128, HTB = HALF * BK * 2, STAGE_BYTES = 8 * HTB, NXCD = 8, WGM = 8;
__host__ __device__ __forceinline__ int lds_byte(int r, int c) { const int st = (r >> 4) * 2 + (c >> 5), rr = r & 15, cc = c & 31, ob = rr * 64 + cc * 2; return st * 1024 + (ob ^ (((ob >> 9) & 1) << 5)); }
__host__ __device__ __forceinline__ void stage_rc(int b, int& R, int& C) { const int st = b / 1024, sb = b % 1024, swz = sb ^ (((sb >> 9) & 1) << 5); R = (st >> 1) * 16 + swz / 64; C = (st & 1) * 32 + (swz % 64) / 2; }
__host__ __device__ __forceinline__ int perm32(int rho) { const int n = rho >> 4, i = rho & 15; return 8 * (i >> 2) + 4 * n + (i & 3); }

struct Unit { int pm, pn, hsel, half, which; };
struct Gemm { const bf16_t* A; const bf16_t* Bt; int M, N, K; const bf16_t* A2; const bf16_t* Bt2; };

struct StaticOrder {
    int nM, nN, nwg, G, c;
    __host__ __device__ void init(int M, int N, int G_, int c_) { nM = M / BM; nN = N / BM; nwg = nM * nN; G = G_; c = c_; }
    __host__ __device__ bool next(int i, Unit& u) const {
        const long L = (long)i * G + c; if (L >= nwg) return false;
        int wgid = (int)L; { const int q = nwg / NXCD, r = nwg % NXCD, xcd = wgid % NXCD, off = wgid / NXCD; wgid = (xcd < r ? xcd * (q + 1) : r * (q + 1) + (xcd - r) * q) + off; }
        const int nig = WGM * nN, gid = wgid / nig, fm = gid * WGM, gsz = (nM - fm) < WGM ? (nM - fm) : WGM;
        u.pm = fm + ((wgid % nig) % gsz); u.pn = (wgid % nig) / gsz; u.hsel = 0; u.half = 0; u.which = 0; return true;
    }
};

struct PairOrder {
    StaticOrder S;
    __host__ __device__ bool next(int i, Unit& u) const { if (!S.next(i >> 1, u)) return false; u.which = i & 1; return true; }
};

struct TailSplitOrder {
    StaticOrder S;
    __host__ __device__ bool next(int i, Unit& u) const {
        const int full = S.nwg / S.G, rem = S.nwg - full * S.G;
        if (i < full || 2 * rem != S.G) return S.next(i, u);
        if (i > full) return false;
        StaticOrder S2 = S; S2.c = S.c % rem;
        if (!S2.next(full, u)) return false;
        u.hsel = S.c / rem; u.half = 1; return true;
    }
};

template <class Epi, class Order>
__device__ __forceinline__ void gemm_phase(LAS unsigned char* lds, const Gemm g, const Order& S, const Epi& E) {
    int tid = threadIdx.x; asm volatile("" : "+v"(tid));
    const int wid = __builtin_amdgcn_readfirstlane(tid >> 6), lane = tid & 63, wr = wid >> 2, wc = wid & 3, fr = lane & 15, fq = lane >> 4;
    const int K = g.K, nt = K / BK;
    unsigned voffA[2], voffB[2];
#pragma unroll
    for (int i = 0; i < 2; ++i) { int R, C; stage_rc(tid * 16 + i * 8192, R, C); const int Rb = (R & ~31) + perm32(R & 31);
        voffA[i] = (unsigned)(R * K + C) * 2u; voffB[i] = (unsigned)(Rb * K + C) * 2u; }
    const size_t kstep = (size_t)(BK * 2);
    const size_t hstep = (size_t)HALF * K * 2;
    const size_t tstep = 2 * hstep;
    const unsigned ldsw = (unsigned)wid * 1024u;
    const int aoff = lds_byte(wr * 64 + fr, fq * 8), boff = lds_byte(wc * 32 + fr, fq * 8);
#define PG8_SA(b, h) (((b) * 2 + (h)) * HTB)
#define PG8_SB(b, h) ((4 + (b) * 2 + (h)) * HTB)
#define PG8_STAGE(bufoff, gbase, voff) do { _Pragma("unroll") for (int _i = 0; _i < 2; ++_i) \
        __builtin_amdgcn_global_load_lds((const unsigned*)((const char*)(gbase) + (voff)[_i]), (LAS unsigned*)(lds + (bufoff) + ldsw + _i * 8192), 16, 0, 0); } while (0)
#define PG8_LDA(dst, b, h) do { _Pragma("unroll") for (int m = 0; m < 4; ++m) _Pragma("unroll") for (int k = 0; k < 2; ++k) dst[m][k] = *(const LAS bf16x8*)(lds + PG8_SA(b, h) + aoff + m * 2048 + k * 1024); } while (0)
#define PG8_LDB(dst, b, h) do { _Pragma("unroll") for (int n = 0; n < 2; ++n) _Pragma("unroll") for (int k = 0; k < 2; ++k) dst[n][k] = *(const LAS bf16x8*)(lds + PG8_SB(b, h) + boff + n * 2048 + k * 1024); } while (0)
#define PG8_MMA(ai, bj, At, Bt) do { __builtin_amdgcn_s_setprio(1); _Pragma("unroll") for (int m = 0; m < 4; ++m) _Pragma("unroll") for (int n = 0; n < 2; ++n) _Pragma("unroll") for (int k = 0; k < 2; ++k) \
        acc[ai][bj][m][n] = __builtin_amdgcn_mfma_f32_16x16x32_bf16(Bt[n][k], At[m][k], acc[ai][bj][m][n], 0, 0, 0); __builtin_amdgcn_s_setprio(0); } while (0)
#define PG8_WAIT_V(n) asm volatile("s_waitcnt vmcnt(" #n ")" ::: "memory")
#define PG8_WAIT_L(n) asm volatile("s_waitcnt lgkmcnt(" #n ")" ::: "memory")
#define PG8_BAR __builtin_amdgcn_s_barrier()
#define PG8_SCHED __builtin_amdgcn_sched_barrier(0)
    Unit cur, nxt; int ui = 0;
    if (!S.next(0, cur)) return;
    f32x4 acc[2][2][4][2];
#pragma unroll
    for (int a = 0; a < 2; ++a)
#pragma unroll
        for (int b = 0; b < 2; ++b)
#pragma unroll
            for (int m = 0; m < 4; ++m)
#pragma unroll
                for (int n = 0; n < 2; ++n) acc[a][b][m][n] = (f32x4){0.f, 0.f, 0.f, 0.f};
    bf16x8 At[4][2], B0[2][2], B1[2][2];
    const char* cA = (const char*)(cur.which ? g.A2 : g.A) + (size_t)cur.pm * tstep + (size_t)cur.hsel * hstep; const char* cB = (const char*)(cur.which ? g.Bt2 : g.Bt) + (size_t)cur.pn * tstep;
    PG8_STAGE(PG8_SB(0, 0), cB, voffB); PG8_STAGE(PG8_SB(0, 1), cB + hstep, voffB); PG8_STAGE(PG8_SA(0, 0), cA, voffA); PG8_STAGE(PG8_SA(0, 1), cA + hstep, voffA);
    if (wr == 1) PG8_BAR;
    PG8_WAIT_V(2); PG8_BAR;
    PG8_STAGE(PG8_SB(1, 0), cB + kstep, voffB); PG8_STAGE(PG8_SA(1, 0), cA + kstep, voffA); PG8_STAGE(PG8_SB(1, 1), cB + hstep + kstep, voffB);
    PG8_WAIT_V(6); PG8_BAR;
    for (;;) {
        const bool has_next = S.next(ui + 1, nxt);
        const char* nA = has_next ? (const char*)(nxt.which ? g.A2 : g.A) + (size_t)nxt.pm * tstep + (size_t)nxt.hsel * hstep : cA; const char* nB = has_next ? (const char*)(nxt.which ? g.Bt2 : g.Bt) + (size_t)nxt.pn * tstep : cB;
        for (int t = 0; t < nt; t += 2) {
            const bool last = (t == nt - 2);
            const char* a1 = cA + (size_t)(t + 1) * kstep;
            const char* a2 = last ? nA : cA + (size_t)(t + 2) * kstep; const char* b2 = last ? nB : cB + (size_t)(t + 2) * kstep;
            const char* a3 = a2 + kstep; const char* b3 = b2 + kstep;
            PG8_LDB(B0, 0, 0); PG8_LDB(B1, 0, 1); PG8_SCHED; PG8_LDA(At, 0, 0); PG8_STAGE(PG8_SA(1, 1), a1 + hstep, voffA);
            PG8_WAIT_V(8); PG8_WAIT_L(0); PG8_BAR; PG8_MMA(0, 0, At, B0); PG8_MMA(0, 1, At, B1); PG8_BAR; PG8_SCHED;
            PG8_LDA(At, 0, 1); PG8_STAGE(PG8_SB(0, 0), b2, voffB); PG8_STAGE(PG8_SB(0, 1), b2 + hstep, voffB); PG8_STAGE(PG8_SA(0, 0), a2, voffA);
            PG8_WAIT_V(8); PG8_WAIT_L(0); PG8_BAR; if (!cur.half) { PG8_MMA(1, 0, At, B0); PG8_MMA(1, 1, At, B1); } PG8_BAR; PG8_SCHED;
            PG8_LDB(B0, 1, 0); PG8_LDB(B1, 1, 1); PG8_SCHED; PG8_LDA(At, 1, 0); PG8_STAGE(PG8_SA(0, 1), a2 + hstep, voffA);
            PG8_WAIT_V(8); PG8_WAIT_L(0); PG8_BAR; PG8_MMA(0, 0, At, B0); PG8_MMA(0, 1, At, B1); PG8_BAR; PG8_SCHED;
            PG8_LDA(At, 1, 1); PG8_STAGE(PG8_SB(1, 0), b3, voffB); PG8_STAGE(PG8_SB(1, 1), b3 + hstep, voffB); PG8_STAGE(PG8_SA(1, 0), a3, voffA);
            PG8_WAIT_V(8); PG8_WAIT_L(0); PG8_BAR; if (!cur.half) { PG8_MMA(1, 0, At, B0); PG8_MMA(1, 1, At, B1); } PG8_BAR; PG8_SCHED;
        }
        if (wr == 0) PG8_BAR;
        bool keep = false;
        if constexpr (Epi::FUSE_PAIR) { if (cur.which == 0) { E.mid(acc, cur, wr, wc, fr, fq); keep = true; } else E(acc, cur, wr, wc, fr, fq); }
        else E(acc, cur, wr, wc, fr, fq);
        if (!has_next) break;
        if (!keep) {
#pragma unroll
        for (int a = 0; a < 2; ++a)
#pragma unroll
            for (int b = 0; b < 2; ++b)
#pragma unroll
                for (int m = 0; m < 4; ++m)
#pragma unroll
                    for (int n = 0; n < 2; ++n) acc[a][b][m][n] = (f32x4){0.f, 0.f, 0.f, 0.f};
        }
        cur = nxt; cA = nA; cB = nB; ++ui;
        if (wr == 1) PG8_BAR;
    }
    PG8_WAIT_V(0);
    PG8_BAR;
#undef PG8_SA
#undef PG8_SB
#undef PG8_STAGE
#undef PG8_LDA
#undef PG8_LDB
#undef PG8_MMA
#undef PG8_WAIT_V
#undef PG8_WAIT_L
#undef PG8_BAR
#undef PG8_SCHED
}
}
using pg8::Unit;

#define ACC_T const f32x4 (&acc)[2][2][4][2]

struct EpiSwiglu {
    static constexpr bool FUSE_PAIR = false;
    unsigned char* ws; int ssi;
    __device__ __forceinline__ void operator()(ACC_T, const Unit& u, int wr, int wc, int fr, int fq) const {
        const int p0 = wc * 32 + 8 * fq;
        bf16_t* H = (bf16_t*)(ws + OFF_BIG); const float* ss = (const float*)(ws + OFF_SS) + (size_t)ssi * T;
        float rs[8];
#pragma unroll
        for (int i = 0; i < 8; ++i) rs[i] = ss[u.pm * 256 + (i >> 2) * 128 + wr * 64 + (i & 3) * 16 + fr];
#pragma unroll
        for (int ai = 0; ai < 2; ++ai)
#pragma unroll
            for (int m = 0; m < 4; ++m) {
                const int row = u.pm * 256 + ai * 128 + wr * 64 + m * 16 + fr;
                const float rstd = rsqrtf(rs[ai * 4 + m] * (1.f / 1024.f) + EPS);
                float h[8];
#pragma unroll
                for (int n = 0; n < 2; ++n)
#pragma unroll
                    for (int e = 0; e < 4; ++e) { const float gv = acc[ai][0][m][n][e] * rstd, uv = acc[ai][1][m][n][e] * rstd; h[4 * n + e] = gv * sigm(gv) * uv; }
                __builtin_nontemporal_store(pack8(h), (u32x4*)(H + (size_t)row * FFP + u.pn * 128 + p0));
            }
    }
};

template <bool BASE_F32> struct EpiResid {
    static constexpr bool FUSE_PAIR = false;
    const float* basef; unsigned char* ws; int ssi; float scale;
    __device__ __forceinline__ void operator()(ACC_T, const Unit& u, int wr, int wc, int fr, int fq) const {
        const int p0 = wc * 32 + 8 * fq;
        bf16_t* xb = (bf16_t*)(ws + OFF_XB); float* ss = (float*)(ws + OFF_SS) + (size_t)ssi * T;
#pragma unroll
        for (int ai = 0; ai < 2; ++ai) {
            f32x4 bb[4][2][2];
#pragma unroll
            for (int m = 0; m < 4; ++m)
#pragma unroll
                for (int bj = 0; bj < 2; ++bj) { const size_t off = (size_t)(u.pm * 256 + ai * 128 + wr * 64 + m * 16 + fr) * D + u.pn * 256 + bj * 128 + p0;
                    if (BASE_F32) { bb[m][bj][0] = *(const f32x4*)(basef + off); bb[m][bj][1] = *(const f32x4*)(basef + off + 4); }
                    else { const u32x4 bw = *(const u32x4*)(xb + off); bb[m][bj][0] = __builtin_bit_cast(f32x4, bw); } }
            float sqm[4];
#pragma unroll
            for (int m = 0; m < 4; ++m) {
                const int row = u.pm * 256 + ai * 128 + wr * 64 + m * 16 + fr;
                float sq = 0.f;
#pragma unroll
                for (int bj = 0; bj < 2; ++bj) {
                    const size_t off = (size_t)row * D + u.pn * 256 + bj * 128 + p0;
                    f32x4 b0, b1;
                    if (BASE_F32) { b0 = bb[m][bj][0]; b1 = bb[m][bj][1]; }
                    else { const u32x4 bw = __builtin_bit_cast(u32x4, bb[m][bj][0]); b0 = (f32x4){bflo(bw.x), bfhi(bw.x), bflo(bw.y), bfhi(bw.y)}; b1 = (f32x4){bflo(bw.z), bfhi(bw.z), bflo(bw.w), bfhi(bw.w)}; }
                    const f32x4 o0 = b0 + acc[ai][bj][m][0] * scale, o1 = b1 + acc[ai][bj][m][1] * scale;
                    sq += (o0[0] * o0[0] + o0[1] * o0[1]) + (o0[2] * o0[2] + o0[3] * o0[3]) + (o1[0] * o1[0] + o1[1] * o1[1]) + (o1[2] * o1[2] + o1[3] * o1[3]);
                    u32x4 w; w.x = cvt_pk_bf16(o0[0], o0[1]); w.y = cvt_pk_bf16(o0[2], o0[3]); w.z = cvt_pk_bf16(o1[0], o1[1]); w.w = cvt_pk_bf16(o1[2], o1[3]); *(u32x4*)(xb + off) = w;
                }
                sq += __shfl_xor(sq, 16); sq += __shfl_xor(sq, 32);
                sqm[m] = sq;
            }
            const float v = fq == 0 ? sqm[0] : fq == 1 ? sqm[1] : fq == 2 ? sqm[2] : sqm[3];
            atomicAdd(ss + (u.pm * 256 + ai * 128 + wr * 64 + fq * 16 + fr), v);
        }
    }
};

struct EpiGate {
    static constexpr bool FUSE_PAIR = true;
    unsigned char* ws;
    __device__ __forceinline__ void mid(f32x4 (&acc)[2][2][4][2], const Unit& u, int wr, int wc, int fr, int fq) const {
        asm volatile("" : "+v"(fr), "+v"(fq));
        const int p0 = wc * 32 + 8 * fq;
        const unsigned char* gr = (const unsigned char*)(ws + OFF_SR); const unsigned char* ga = (const unsigned char*)(ws + OFF_SA);
#pragma unroll
        for (int ai = 0; ai < 2; ++ai) {
            u32x2 rv[4][2], av[4][2];
#pragma unroll
            for (int m = 0; m < 4; ++m)
#pragma unroll
                for (int bj = 0; bj < 2; ++bj) { const int off = (u.pm * 256 + ai * 128 + wr * 64 + m * 16 + fr) * D + u.pn * 256 + bj * 128 + p0;
                    rv[m][bj] = *(const u32x2*)(gr + off); av[m][bj] = *(const u32x2*)(ga + off); }
#pragma unroll
            for (int m = 0; m < 4; ++m)
#pragma unroll
                for (int bj = 0; bj < 2; ++bj) {
                    const u32x2 r = rv[m][bj], a = av[m][bj];
#pragma unroll
                    for (int e = 0; e < 4; ++e) {
                        acc[ai][bj][m][0][e] *= (float)((r.x >> (8 * e)) & 0xffu) * __builtin_amdgcn_rcpf((float)((a.x >> (8 * e)) & 0xffu));
                        acc[ai][bj][m][1][e] *= (float)((r.y >> (8 * e)) & 0xffu) * __builtin_amdgcn_rcpf((float)((a.y >> (8 * e)) & 0xffu)); }
                }
        }
    }
    __device__ __forceinline__ void operator()(ACC_T, const Unit& u, int wr, int wc, int fr, int fq) const {
        asm volatile("" : "+v"(fr), "+v"(fq));
        const int p0 = wc * 32 + 8 * fq;
        bf16_t* MG = (bf16_t*)(ws + OFF_MG); const unsigned char* ga = (const unsigned char*)(ws + OFF_SA);
#pragma unroll
        for (int ai = 0; ai < 2; ++ai) {
            u32x2 av[4][2];
#pragma unroll
            for (int m = 0; m < 4; ++m)
#pragma unroll
                for (int bj = 0; bj < 2; ++bj) av[m][bj] = *(const u32x2*)(ga + (u.pm * 256 + ai * 128 + wr * 64 + m * 16 + fr) * D + u.pn * 256 + bj * 128 + p0);
#pragma unroll
            for (int m = 0; m < 4; ++m)
#pragma unroll
                for (int bj = 0; bj < 2; ++bj) {
                    const int off = (u.pm * 256 + ai * 128 + wr * 64 + m * 16 + fr) * D + u.pn * 256 + bj * 128 + p0;
                    const u32x2 a = av[m][bj]; const float q = 1.f / 255.f;
                    float v[8];
#pragma unroll
                    for (int e = 0; e < 4; ++e) { v[e] = acc[ai][bj][m][0][e] * ((float)((a.x >> (8 * e)) & 0xffu) * q); v[4 + e] = acc[ai][bj][m][1][e] * ((float)((a.y >> (8 * e)) & 0xffu) * q); }
                    *(u32x4*)(MG + off) = pack8(v);
                }
        }
    }
};

struct EpiProj {
    static constexpr bool FUSE_PAIR = false;
    unsigned char* ws;
    __device__ __forceinline__ void operator()(ACC_T, const Unit& u, int wr, int wc, int fr, int fq) const {
        asm volatile("" : "+v"(fr), "+v"(fq));
        const int pn = u.pn, p0 = wc * 32 + 8 * fq;
        const float* ss = (const float*)(ws + OFF_SS) + T; const f32x4* tabR = (const f32x4*)(ws + OFF_TABR); const f32x4* tabA = (const f32x4*)(ws + OFF_TABA); const f32x4* dt = (const f32x4*)(ws + OFF_DT);
        bf16_t *QR = (bf16_t*)(ws + OFF_QR), *KR = (bf16_t*)(ws + OFF_KR), *KFT = (bf16_t*)(ws + OFF_KFT), *KBT = (bf16_t*)(ws + OFF_KBT), *VRT = (bf16_t*)(ws + OFF_VRT), *GR = (bf16_t*)(ws + OFF_GR),
               *QA = (bf16_t*)(ws + OFF_QA), *KA = (bf16_t*)(ws + OFF_KA), *VAT = (bf16_t*)(ws + OFF_VAT), *SR = (bf16_t*)(ws + OFF_SR), *SA = (bf16_t*)(ws + OFF_SA);
        const int rbase = u.pm * 256 + u.hsel * 128 + wr * 64 + fr;
        float rs[8];
#pragma unroll
        for (int i = 0; i < 8; ++i) rs[i] = ss[rbase + (i >> 2) * 128 + (i & 3) * 16];
        const bool ropeR = pn < 4, ropeA = (pn >= 8 && pn < 10) || (pn == 10 && wc < 2);
        f32x4 tn[4];
        if (ropeR || ropeA) { const int s0 = rbase & (SEQ - 1); const f32x4* tp0 = ropeR ? tabR + ((size_t)s0 * 64 + (p0 & 63)) / 2 : tabA + ((size_t)s0 * 32 + (p0 & 31)) / 2;
#pragma unroll
            for (int q = 0; q < 4; ++q) tn[q] = tp0[q]; }
#pragma unroll
        for (int ai = 0; ai < 2; ++ai)
#pragma unroll
            for (int m = 0; m < 4; ++m) {
                if (ai == 1 && u.half) continue;
                const int row = rbase + ai * 128 + m * 16;
                const float rstd = rsqrtf(rs[ai * 4 + m] * (1.f / 1024.f) + EPS);
                const int s = row & (SEQ - 1), b = row >> 12;
                f32x4 tc[4];
#pragma unroll
                for (int q = 0; q < 4; ++q) tc[q] = tn[q];
                if ((ropeR || ropeA) && (ai * 4 + m) < 7) { const int i1 = ai * 4 + m + 1; const int s1 = (rbase + (i1 >> 2) * 128 + (i1 & 3) * 16) & (SEQ - 1);
                    const f32x4* tp1 = ropeR ? tabR + ((size_t)s1 * 64 + (p0 & 63)) / 2 : tabA + ((size_t)s1 * 32 + (p0 & 31)) / 2;
#pragma unroll
                    for (int q = 0; q < 4; ++q) tn[q] = tp1[q]; }
                float lo[8], hi[8];
#pragma unroll
                for (int e = 0; e < 4; ++e) { lo[e] = acc[ai][0][m][0][e] * rstd; lo[4 + e] = acc[ai][0][m][1][e] * rstd; hi[e] = acc[ai][1][m][0][e] * rstd; hi[4 + e] = acc[ai][1][m][1][e] * rstd; }
                if (pn < 4) {
                    const int head = 2 * (pn & 1) + (p0 >> 6), j0 = p0 & 63;
                    float o1[8], o2[8];
#pragma unroll
                    for (int q = 0; q < 4; ++q) { const f32x4 cs = tc[q];
                        o1[2 * q] = lo[2 * q] * cs[0] - hi[2 * q] * cs[1]; o2[2 * q] = lo[2 * q] * cs[1] + hi[2 * q] * cs[0];
                        o1[2 * q + 1] = lo[2 * q + 1] * cs[2] - hi[2 * q + 1] * cs[3]; o2[2 * q + 1] = lo[2 * q + 1] * cs[3] + hi[2 * q + 1] * cs[2]; }
                    if (pn < 2) {
                        bf16_t* qp = QR + (size_t)row * 512 + head * 128 + j0;
                        *(u32x4*)qp = pack8(o1); *(u32x4*)(qp + 64) = pack8(o2);
                    } else {
                        const float ksc = 0.08838834764831845f;
#pragma unroll
                        for (int e = 0; e < 8; ++e) { o1[e] *= ksc; o2[e] *= ksc; }
                        bf16_t* kp = KR + (((size_t)(b * 4 + head) * 32 + (s >> 7)) * 128 + (s & 127)) * 128;
                        *(u32x4*)(kp + (((j0 >> 3) ^ (s & 15)) << 3)) = pack8(o1); *(u32x4*)(kp + ((((j0 >> 3) + 8) ^ (s & 15)) << 3)) = pack8(o2);
                        const f32x4 dd = dt[head * 128 + (s & 127)];
                        const size_t tb = (((size_t)(b * 4 + head) * 32 + (s >> 7)) * 128 + j0) * 128 + (s & 7);
                        const int tc = (s & 127) >> 3;
#pragma unroll
                        for (int e = 0; e < 8; ++e) { const int sw = ((tc ^ ((j0 + e) & 15)) << 3);
                            KFT[tb + (size_t)e * 128 + sw] = f2bf(o1[e] * dd[2]); KFT[tb + (size_t)(64 + e) * 128 + sw] = f2bf(o2[e] * dd[2]);
                            KBT[tb + (size_t)e * 128 + sw] = f2bf(o1[e] * dd[3]); KBT[tb + (size_t)(64 + e) * 128 + sw] = f2bf(o2[e] * dd[3]);
                        }
                    }
                } else if (pn < 6) {
                    const int h0 = 2 * (pn - 4);
                    const size_t tb = (((size_t)(b * 4 + h0) * 32 + (s >> 7)) * 128 + p0) * 128 + (s & 7);
                    const int tc = (s & 127) >> 3;
#pragma unroll
                    for (int e = 0; e < 8; ++e) { const int sw = ((tc ^ ((p0 + e) & 15)) << 3); VRT[tb + (size_t)e * 128 + sw] = f2bf(lo[e]); VRT[tb + (size_t)32 * 16384 + (size_t)e * 128 + sw] = f2bf(hi[e]); }
                } else if (pn < 8) {
#pragma unroll
                    for (int e = 0; e < 8; ++e) { lo[e] = lo[e] * sigm(lo[e]); hi[e] = hi[e] * sigm(hi[e]); }
                    bf16_t* gp = GR + (size_t)row * 512 + (pn - 6) * 256 + p0;
                    *(u32x4*)gp = pack8(lo); *(u32x4*)(gp + 128) = pack8(hi);
                } else if (pn < 10 || (pn == 10 && wc < 2)) {
                    const int j0 = p0 & 31;
                    float o1[8], o2[8];
                    const float sc = (pn < 10) ? 0.125f : 1.0f;
#pragma unroll
                    for (int q = 0; q < 4; ++q) { const f32x4 cs = tc[q];
                        o1[2 * q] = (lo[2 * q] * cs[0] - hi[2 * q] * cs[1]) * sc; o2[2 * q] = (lo[2 * q] * cs[1] + hi[2 * q] * cs[0]) * sc;
                        o1[2 * q + 1] = (lo[2 * q + 1] * cs[2] - hi[2 * q + 1] * cs[3]) * sc; o2[2 * q + 1] = (lo[2 * q + 1] * cs[3] + hi[2 * q + 1] * cs[2]) * sc; }
                    if (pn < 10) { bf16_t* dp = QA + (size_t)row * 512 + (4 * (pn - 8) + (p0 >> 5)) * 64 + j0; *(u32x4*)dp = pack8(o1); *(u32x4*)(dp + 32) = pack8(o2); }
                    else {
                        bf16_t* dp = KA + ((((size_t)(b * 2 + (p0 >> 5)) * 32 + (s >> 7)) * 128 + (s & 127)) << 6); const int sw = ((s & 127) >> 1) & 7;
                        *(u32x4*)(dp + (((j0 >> 3) ^ sw) << 3)) = pack8(o1); *(u32x4*)(dp + ((((j0 >> 3) + 4) ^ sw) << 3)) = pack8(o2); }
                } else if (pn == 10) {
                    const int d0 = p0 - 64;
                    const size_t tb = (((size_t)(b * 2) * 32 + (s >> 7)) * 64 + d0) * 128 + (s & 7);
                    const int tc = (s & 127) >> 3;
#pragma unroll
                    for (int e = 0; e < 8; ++e) { const int sw = ((tc ^ ((d0 + e) & 15)) << 3); VAT[tb + (size_t)e * 128 + sw] = f2bf(lo[e]); VAT[tb + (size_t)32 * 8192 + (size_t)e * 128 + sw] = f2bf(hi[e]); }
                } else {
#pragma unroll
                    for (int e = 0; e < 8; ++e) { lo[e] = sigm(lo[e]); hi[e] = sigm(hi[e]); }
                    unsigned char* gp = (ws + (pn < 15 ? OFF_SR : OFF_SA)) + (row * D + (pn < 15 ? pn - 11 : pn - 15) * 256 + p0);
                    if (pn >= 15) {
#pragma unroll
                        for (int e = 0; e < 8; ++e) { lo[e] = fmaxf(lo[e], 1.5f / 255.f); hi[e] = fmaxf(hi[e], 1.5f / 255.f); } }
                    u32x2 wl, wh;
                    wl.x = __builtin_amdgcn_cvt_pk_u8_f32(lo[3] * 255.f, 3, __builtin_amdgcn_cvt_pk_u8_f32(lo[2] * 255.f, 2, __builtin_amdgcn_cvt_pk_u8_f32(lo[1] * 255.f, 1, __builtin_amdgcn_cvt_pk_u8_f32(lo[0] * 255.f, 0, 0u))));
                    wl.y = __builtin_amdgcn_cvt_pk_u8_f32(lo[7] * 255.f, 3, __builtin_amdgcn_cvt_pk_u8_f32(lo[6] * 255.f, 2, __builtin_amdgcn_cvt_pk_u8_f32(lo[5] * 255.f, 1, __builtin_amdgcn_cvt_pk_u8_f32(lo[4] * 255.f, 0, 0u))));
                    wh.x = __builtin_amdgcn_cvt_pk_u8_f32(hi[3] * 255.f, 3, __builtin_amdgcn_cvt_pk_u8_f32(hi[2] * 255.f, 2, __builtin_amdgcn_cvt_pk_u8_f32(hi[1] * 255.f, 1, __builtin_amdgcn_cvt_pk_u8_f32(hi[0] * 255.f, 0, 0u))));
                    wh.y = __builtin_amdgcn_cvt_pk_u8_f32(hi[7] * 255.f, 3, __builtin_amdgcn_cvt_pk_u8_f32(hi[6] * 255.f, 2, __builtin_amdgcn_cvt_pk_u8_f32(hi[5] * 255.f, 1, __builtin_amdgcn_cvt_pk_u8_f32(hi[4] * 255.f, 0, 0u))));
                    *(u32x2*)gp = wl; *(u32x2*)(gp + 128) = wh;
                }
            }
    }
};

struct MapFfnIn { __device__ __forceinline__ int operator()(int n) const { const int r = n & 255, ffi = (n >> 8) * 128 + (r & 127); if (ffi >= FF) return -1; return r < 128 ? ffi : FF + ffi; } };
struct MapNat { __device__ __forceinline__ int operator()(int n) const { return n; } };
struct MapWin { __device__ __forceinline__ int operator()(int n) const {
    const int t = n >> 8, r = n & 255, rl = r & 127, hf = r >> 7;
    if (t < 2) return (2 * t + (rl >> 6)) * 128 + hf * 64 + (rl & 63);
    if (t < 4) return 512 + (2 * (t - 2) + (rl >> 6)) * 128 + hf * 64 + (rl & 63);
    if (t < 8) return 1024 + (t - 4) * 256 + r;
    if (t < 10) return 2048 + (4 * (t - 8) + (rl >> 5)) * 64 + hf * 32 + (rl & 31);
    if (t == 10) { if (rl < 64) return 2560 + (rl >> 5) * 64 + hf * 32 + (rl & 31); return 2688 + hf * 64 + (rl - 64); }
    return 2816 + (t - 11) * 256 + r;
} };

template <class Map>
__device__ __forceinline__ void tr_item(const float* W, int Ksrc, int Nsrc, bf16_t* WT, int Kdst, const float* gain, LAS float* scr, int kb, int nb, int lane, Map map) {
    const int k0 = 64 * kb, n0 = 32 * nb, sc = map(n0);
    const bool valid = (sc >= 0) && (k0 < Ksrc);
    float tv[32];
#pragma unroll
    for (int i = 0; i < 32; ++i) { const int kk = 2 * i + (lane >> 5); tv[i] = valid ? W[(size_t)(k0 + kk) * Nsrc + sc + (lane & 31)] : 0.f; }
#pragma unroll
    for (int i = 0; i < 32; ++i) { const int kk = 2 * i + (lane >> 5); scr[kk * 33 + (lane & 31)] = tv[i]; }
    asm volatile("s_waitcnt vmcnt(0) lgkmcnt(0)" ::: "memory");
    const int c = lane & 7;
    float gk[8];
#pragma unroll
    for (int e = 0; e < 8; ++e) gk[e] = (gain && valid) ? gain[k0 + 8 * c + e] : 1.f;
#pragma unroll
    for (int j = 0; j < 4; ++j) { const int n = (lane >> 3) + 8 * j; const LAS float* sp = scr + (8 * c) * 33 + n;
        float v[8];
#pragma unroll
        for (int e = 0; e < 8; ++e) v[e] = sp[e * 33] * gk[e];
        *(u32x4*)(WT + (size_t)(n0 + n) * Kdst + k0 + 8 * c) = pack8(v); }
    asm volatile("s_waitcnt lgkmcnt(0)" ::: "memory");
}

__device__ __forceinline__ void p0_prologue(const Params& P, LAS unsigned char* lds, int wid, int lane) {
    unsigned char* ws = P.ws;
    LAS float* scr = (LAS float*)(lds + wid * 16384);
    const int G = gridDim.x, gw = blockIdx.x * 8 + wid, NGW = G * 8, gt = blockIdx.x * 512 + threadIdx.x, NT = G * 512;
    constexpr int I_FI = 16 * (NFF2 / 32), I_FO = (FFP / 64) * 32, I_IN = 16 * (NIN / 32), I_RO = 8 * 32, I_OUT = 16 * 32;
    constexpr int NITEMS = 2 * I_FI + 2 * I_FO + I_IN + 2 * I_RO + I_OUT;
    for (int it = gw; it < NITEMS; it += NGW) {
        int r = it;
        if (r < I_FI) { tr_item(P.w1i, D, 2 * FF, (bf16_t*)(ws + OFF_W1T), D, P.g1, scr, r / (NFF2 / 32), r % (NFF2 / 32), lane, MapFfnIn()); continue; } r -= I_FI;
        if (r < I_FI) { tr_item(P.w2i, D, 2 * FF, (bf16_t*)(ws + OFF_W2T), D, P.g2, scr, r / (NFF2 / 32), r % (NFF2 / 32), lane, MapFfnIn()); continue; } r -= I_FI;
        if (r < I_FO) { tr_item(P.w1o, FF, D, (bf16_t*)(ws + OFF_W1O), FFP, nullptr, scr, r / 32, r % 32, lane, MapNat()); continue; } r -= I_FO;
        if (r < I_FO) { tr_item(P.w2o, FF, D, (bf16_t*)(ws + OFF_W2O), FFP, nullptr, scr, r / 32, r % 32, lane, MapNat()); continue; } r -= I_FO;
        if (r < I_IN) { tr_item(P.win, D, NIN, (bf16_t*)(ws + OFF_WIN), D, P.gmix, scr, r / (NIN / 32), r % (NIN / 32), lane, MapWin()); continue; } r -= I_IN;
        if (r < I_RO) { tr_item(P.wret, 512, D, (bf16_t*)(ws + OFF_WRET), 512, nullptr, scr, r / 32, r % 32, lane, MapNat()); continue; } r -= I_RO;
        if (r < I_RO) { tr_item(P.watt, 512, D, (bf16_t*)(ws + OFF_WATT), 512, nullptr, scr, r / 32, r % 32, lane, MapNat()); continue; } r -= I_RO;
        tr_item(P.wout, D, D, (bf16_t*)(ws + OFF_WOUT), D, nullptr, scr, r / 32, r % 32, lane, MapNat());
    }
    float* ss = (float*)(ws + OFF_SS);
    bf16_t* XB = (bf16_t*)(ws + OFF_XB);
    for (int row0 = gw; row0 < T; row0 += 4 * NGW) {
        f32x4 v[4][4];
#pragma unroll
        for (int r = 0; r < 4; ++r) { const f32x4* xr = (const f32x4*)(P.x + (size_t)(row0 + r * NGW) * D) + lane;
#pragma unroll
            for (int j = 0; j < 4; ++j) v[r][j] = xr[64 * j]; }
#pragma unroll
        for (int r = 0; r < 4; ++r) { const int row = row0 + r * NGW; float sq = 0.f;
#pragma unroll
            for (int j = 0; j < 4; ++j) sq += (v[r][j][0] * v[r][j][0] + v[r][j][1] * v[r][j][1]) + (v[r][j][2] * v[r][j][2] + v[r][j][3] * v[r][j][3]);
#pragma unroll
            for (int o = 1; o < 64; o <<= 1) sq += __shfl_xor(sq, o);
            u32x2* o8 = (u32x2*)(XB + (size_t)row * D) + lane;
#pragma unroll
            for (int j = 0; j < 4; ++j) { u32x2 w; w.x = cvt_pk_bf16(v[r][j][0], v[r][j][1]); w.y = cvt_pk_bf16(v[r][j][2], v[r][j][3]); o8[64 * j] = w; }
            if (lane == 0) ss[row] = sq; }
    }
    for (int i = gt; i < 3 * T; i += NT) ss[T + i] = 0.f;
    f32x2* tabR = (f32x2*)(ws + OFF_TABR); f32x2* tabA = (f32x2*)(ws + OFF_TABA);
    const double L2T = 13.287712379549449;
    const double INV2PI = 0.15915494309189535;
    for (int i = gt; i < SEQ * 64; i += NT) { const int s = i >> 6, j = i & 63; const float invf = (float)exp2(-(double)j * (1.0 / 64.0) * L2T);
        const float ang = (float)s * invf; double rev = (double)ang * INV2PI; rev -= rint(rev);
        tabR[i] = (f32x2){__builtin_amdgcn_cosf((float)rev), __builtin_amdgcn_sinf((float)rev)}; }
    for (int i = gt; i < SEQ * 32; i += NT) { const int s = i >> 5, j = i & 31; const float invf = (float)exp2(-(double)j * (1.0 / 32.0) * L2T);
        const float ang = (float)s * invf; double rev = (double)ang * INV2PI; rev -= rint(rev);
        tabA[i] = (f32x2){__builtin_amdgcn_cosf((float)rev), __builtin_amdgcn_sinf((float)rev)}; }
    { float* sm = (float*)(ws + OFF_SM);
      if (gt < 4) { sm[gt] = -expf(P.dfw[gt]); sm[4 + gt] = -expf(P.dbw[gt]); }
      if (gt < 8) sm[8 + gt] = P.sink[gt];
      if (gt < 512) sm[64 + gt] = P.gng[gt]; }
    if (gt < 512) { const int h = gt >> 7, i = gt & 127; const float lgf = -expf(P.dfw[h]), lgb = -expf(P.dbw[h]);
        ((f32x4*)(ws + OFF_DT))[gt] = (f32x4){expf(lgf * (float)(i + 1)), expf(lgb * (float)(128 - i)), expf(lgf * (float)(127 - i)), expf(lgb * (float)i)}; }
}

__device__ __forceinline__ void attn_unit(unsigned char* ws, LAS unsigned char* lds, int u, int wid, int lane) {
    asm volatile("" : "+v"(lane));
    const int blk = u & 31, bk = u >> 5, hk = bk & 1, b = bk >> 1, fr = lane & 15, g = lane >> 4;
    bf16_t* QA = (bf16_t*)(ws + OFF_QA);
    const char* srcK = (const char*)(ws + OFF_KA) + ((size_t)bk * 32 + (blk - 1)) * 16384;
    const char* srcV = (const char*)(ws + OFF_VAT) + ((size_t)bk * 32 + (blk - 1)) * 16384;
    __syncthreads();
#pragma unroll
    for (int j = 0; j < 6; ++j) { const int piece = j * 8 + wid, pbk = piece >> 4; const int gb = blk - 1 + pbk;
        if (gb >= 0 && gb < 32) { const size_t go = (size_t)piece * 1024 + lane * 16;
            __builtin_amdgcn_global_load_lds((const unsigned*)(srcK + go), (LAS unsigned*)(lds + piece * 1024), 16, 0, 0);
            __builtin_amdgcn_global_load_lds((const unsigned*)(srcV + go), (LAS unsigned*)(lds + 49152 + piece * 1024), 16, 0, 0); } }
    const int q0 = blk * 128 + wid * 16, n = q0 + fr;
    asm volatile("s_waitcnt vmcnt(0)" ::: "memory");
    __syncthreads();
    const LAS unsigned char* krow = lds + fr * 128;
    const LAS unsigned char* vrow = lds + 49152 + fr * 256 + 8 * (g & 1);
#pragma unroll 1
    for (int hp = 0; hp < 2; ++hp) {
        const int head0 = hk * 4 + 2 * hp;
        bf16_t* qp = QA + ((size_t)(b * SEQ + q0 + fr)) * 512 + head0 * 64;
        bf16x8 bq[2][2];
#pragma unroll
        for (int hh = 0; hh < 2; ++hh) { bq[hh][0] = *(const bf16x8*)(qp + hh * 64 + 8 * g); bq[hh][1] = *(const bf16x8*)(qp + hh * 64 + 32 + 8 * g); }
        float m_run[2], l_run[2];
        f32x4 o[2][4];
#pragma unroll
        for (int hh = 0; hh < 2; ++hh) { m_run[hh] = ((const float*)(ws + OFF_SM))[8 + head0 + hh]; l_run[hh] = (g == 0) ? 1.f : 0.f;
#pragma unroll
            for (int rb = 0; rb < 4; ++rb) o[hh][rb] = (f32x4){0.f, 0.f, 0.f, 0.f}; }
#pragma unroll 1
        for (int gq = 0; gq < 3; ++gq) {
            const int kl0 = 16 * wid + 96 * gq;
            const int key0 = q0 - 128 + 96 * gq;
            bf16x8 ka[6][2]; bf16x4 vv[3][4][2]; bool inb[6];
#pragma unroll
            for (int bl = 0; bl < 6; ++bl) { const int kl = kl0 + 16 * bl, kp0 = key0 + 16 * bl; inb[bl] = (kp0 >= 0) && (kp0 < SEQ);
                const LAS unsigned char* kp = krow + (kl >> 7) * 16384 + (kl & 127) * 128;
                ka[bl][0] = *(const LAS bf16x8*)(kp + ((g ^ (fr >> 1)) << 4)); ka[bl][1] = *(const LAS bf16x8*)(kp + (((4 + g) ^ (fr >> 1)) << 4)); }
#pragma unroll
            for (int t = 0; t < 3; ++t)
#pragma unroll
                for (int hf = 0; hf < 2; ++hf) { const int kl = kl0 + 16 * (2 * t + hf); const int vb = inb[2 * t + hf] ? (kl >> 7) : 1;
                    const LAS unsigned char* vp = vrow + vb * 16384 + (((((kl & 127) >> 3) + (g >> 1)) ^ fr) << 4);
#pragma unroll
                    for (int rb = 0; rb < 4; ++rb) vv[t][rb][hf] = *(const LAS bf16x4*)(vp + rb * 4096); }
#pragma unroll
            for (int hh = 0; hh < 2; ++hh) {
                float p[6][4]; float mx = -INFINITY;
#pragma unroll
                for (int bl = 0; bl < 6; ++bl) {
                    f32x4 sacc = (f32x4){0.f, 0.f, 0.f, 0.f};
                    sacc = MFMA16(ka[bl][0], bq[hh][0], sacc); sacc = MFMA16(ka[bl][1], bq[hh][1], sacc);
#pragma unroll
                    for (int i = 0; i < 4; ++i) { const int dd = n - (key0 + 16 * bl + 4 * g + i); const bool ok = inb[bl] && dd <= 128 && dd >= -128; p[bl][i] = ok ? sacc[i] : -INFINITY; mx = fmaxf(mx, p[bl][i]); }
                }
                mx = fmaxf(mx, __shfl_xor(mx, 16)); mx = fmaxf(mx, __shfl_xor(mx, 32));
                const float m_new = fmaxf(m_run[hh], mx), alpha = __expf(m_run[hh] - m_new);
                float ps = 0.f;
#pragma unroll
                for (int bl = 0; bl < 6; ++bl)
#pragma unroll
                    for (int i = 0; i < 4; ++i) { p[bl][i] = __expf(p[bl][i] - m_new); ps += p[bl][i]; }
                l_run[hh] = l_run[hh] * alpha + ps; m_run[hh] = m_new;
#pragma unroll
                for (int rb = 0; rb < 4; ++rb) o[hh][rb] = o[hh][rb] * alpha;
#pragma unroll
                for (int t = 0; t < 3; ++t) {
                    u32x4 pw; pw.x = cvt_pk_bf16(p[2 * t][0], p[2 * t][1]); pw.y = cvt_pk_bf16(p[2 * t][2], p[2 * t][3]); pw.z = cvt_pk_bf16(p[2 * t + 1][0], p[2 * t + 1][1]); pw.w = cvt_pk_bf16(p[2 * t + 1][2], p[2 * t + 1][3]);
                    const bf16x8 pb = __builtin_bit_cast(bf16x8, pw);
#pragma unroll
                    for (int rb = 0; rb < 4; ++rb) { const bf16x8 va = __builtin_shufflevector(vv[t][rb][0], vv[t][rb][1], 0, 1, 2, 3, 4, 5, 6, 7); o[hh][rb] = MFMA16(va, pb, o[hh][rb]); }
                }
            }
        }
#pragma unroll
        for (int hh = 0; hh < 2; ++hh) {
            float l = l_run[hh]; l += __shfl_xor(l, 16); l += __shfl_xor(l, 32);
            const float inv = 1.f / l;
#pragma unroll
            for (int rb = 0; rb < 4; ++rb) { u32x2 w; w.x = cvt_pk_bf16(o[hh][rb][0] * inv, o[hh][rb][1] * inv); w.y = cvt_pk_bf16(o[hh][rb][2] * inv, o[hh][rb][3] * inv);
                *(u32x2*)(qp + hh * 64 + 16 * rb + 4 * g) = w; }
        }
    }
}

__device__ __forceinline__ void r12_unit(unsigned char* ws, bf16_t* kvs, LAS unsigned char* lds, int u, int wid, int lane) {
    asm volatile("" : "+v"(lane));
    const int slice = u & 3, dir = (u >> 2) & 1, bh = u >> 3, h = bh & 3, fr = lane & 15, g = lane >> 4;
    const float gc = expf(128.f * ((const float*)(ws + OFF_SM))[4 * dir + h]);
    const char* KT = (const char*)(ws + (dir ? OFF_KBT : OFF_KFT)) + (size_t)bh * 32 * 32768 + lane * 16;
    const char* VT = (const char*)(ws + OFF_VRT) + (size_t)bh * 32 * 32768 + slice * 8192 + wid * 1024 + lane * 16;
    bf16_t* SO = kvs + ((size_t)bh * 64 + dir) * 16384 + (32 * slice + fr) * 128 + (((2 * wid + (g >> 1)) ^ fr) << 3) + 4 * (g & 1);
    const int c0 = dir ? 31 : 0, cs = dir ? -1 : 1;
    constexpr int STG = 40960;
#define R12_DMA(i) do { const int _c = c0 + (i) * cs; LAS unsigned char* _st = lds + ((i) % 3) * STG; \
        _Pragma("unroll") for (int _j = 0; _j < 4; ++_j) __builtin_amdgcn_global_load_lds((const unsigned*)(KT + (size_t)_c * 32768 + (_j * 8 + wid) * 1024), (LAS unsigned*)(_st + (_j * 8 + wid) * 1024), 16, 0, 0); \
        __builtin_amdgcn_global_load_lds((const unsigned*)(VT + (size_t)_c * 32768), (LAS unsigned*)(_st + 32768 + wid * 1024), 16, 0, 0); } while (0)
    f32x4 S[2] = {(f32x4){0.f, 0.f, 0.f, 0.f}, (f32x4){0.f, 0.f, 0.f, 0.f}};
    asm volatile("s_waitcnt vmcnt(0)" ::: "memory");
    __builtin_amdgcn_s_barrier();
    R12_DMA(0); R12_DMA(1);
    const unsigned aoff = (16 * wid + fr) * 256, boff = 32768 + fr * 256;
#pragma unroll 1
    for (int i = 0; i < 32; ++i) {
        if (i + 2 < 32) R12_DMA(i + 2);
        if (i == 0) asm volatile("s_waitcnt vmcnt(10)" ::: "memory");
        else if (i == 1) asm volatile("s_waitcnt vmcnt(12)" ::: "memory");
        else if (i < 30) asm volatile("s_waitcnt vmcnt(14)" ::: "memory");
        else asm volatile("s_waitcnt vmcnt(4)" ::: "memory");
        __builtin_amdgcn_s_barrier();
        asm volatile("" ::: "memory");
        const LAS unsigned char* st = lds + (i % 3) * STG;
        const int c = c0 + i * cs;
#pragma unroll
        for (int cb = 0; cb < 2; ++cb) { u32x2 w; w.x = cvt_pk_bf16(S[cb][0], S[cb][1]); w.y = cvt_pk_bf16(S[cb][2], S[cb][3]); *(u32x2*)(SO + (size_t)c * 32768 + cb * 2048) = w; }
        f32x4 kv0 = (f32x4){0.f, 0.f, 0.f, 0.f}, kv1 = kv0;
#pragma unroll
        for (int ks = 0; ks < 4; ++ks) { const int sw = (((4 * ks + g) ^ fr) << 4);
            const bf16x8 a = *(const LAS bf16x8*)(st + aoff + sw), b0 = *(const LAS bf16x8*)(st + boff + sw), b1 = *(const LAS bf16x8*)(st + boff + 4096 + sw);
            kv0 = MFMA16(a, b0, kv0); kv1 = MFMA16(a, b1, kv1); }
        S[0] = S[0] * gc + kv0; S[1] = S[1] * gc + kv1;
        asm volatile("s_waitcnt lgkmcnt(0)" ::: "memory");
        __builtin_amdgcn_s_barrier();
        asm volatile("" ::: "memory");
    }
#undef R12_DMA
    asm volatile("s_waitcnt vmcnt(0)" ::: "memory");
}

__device__ __forceinline__ void r3_unit(unsigned char* ws, const bf16_t* kvs, LAS unsigned char* lds, int u, int wid, int lane) {
    asm volatile("" : "+v"(lane));
    const int c = u & 31, bh = u >> 5, h = bh & 3, b = bh >> 2, fr = lane & 15, g = lane >> 4;
    bf16_t* QR = (bf16_t*)(ws + OFF_QR); const bf16_t* GR = (const bf16_t*)(ws + OFF_GR);
    const char* srcK = (const char*)(ws + OFF_KR) + ((size_t)bh * 32 + c) * 32768;
    const char* srcV = (const char*)(ws + OFF_VRT) + ((size_t)bh * 32 + c) * 32768;
    const char* srcS = (const char*)kvs + ((size_t)bh * 32 + c) * 65536;
    __syncthreads();
#pragma unroll
    for (int j = 0; j < 4; ++j) { const int piece = j * 8 + wid; const size_t go = (size_t)piece * 1024 + lane * 16;
        __builtin_amdgcn_global_load_lds((const unsigned*)(srcK + go), (LAS unsigned*)(lds + piece * 1024), 16, 0, 0);
        __builtin_amdgcn_global_load_lds((const unsigned*)(srcV + go), (LAS unsigned*)(lds + 32768 + piece * 1024), 16, 0, 0);
        __builtin_amdgcn_global_load_lds((const unsigned*)(srcS + go), (LAS unsigned*)(lds + 65536 + piece * 1024), 16, 0, 0);
        __builtin_amdgcn_global_load_lds((const unsigned*)(srcS + 32768 + go), (LAS unsigned*)(lds + 98304 + piece * 1024), 16, 0, 0); }
    const int nq = 16 * wid + fr;
    const size_t tokq = (size_t)b * SEQ + c * 128 + nq;
    bf16_t* qp = QR + tokq * 512 + h * 128;
    bf16x8 bq[4];
#pragma unroll
    for (int ks = 0; ks < 4; ++ks) bq[ks] = *(const bf16x8*)(qp + 32 * ks + 8 * g);
    const float lgf = ((const float*)(ws + OFF_SM))[h], lgb = ((const float*)(ws + OFF_SM))[4 + h];
    const f32x4 dq = ((const f32x4*)(ws + OFF_DT))[h * 128 + nq];
    asm volatile("s_waitcnt vmcnt(0)" ::: "memory");
    __syncthreads();
    const LAS unsigned char* rowp = lds + fr * 256;
    bf16x8 pb[4];
#pragma unroll
    for (int kt = 0; kt < 4; ++kt) {
        float pv[8];
#pragma unroll
        for (int hf = 0; hf < 2; ++hf) {
            const int kb = 2 * kt + hf;
            f32x4 sacc = (f32x4){0.f, 0.f, 0.f, 0.f};
#pragma unroll
            for (int ks = 0; ks < 4; ++ks) { const bf16x8 a = *(const LAS bf16x8*)(rowp + kb * 4096 + (((4 * ks + g) ^ fr) << 4)); sacc = MFMA16(a, bq[ks], sacc); }
#pragma unroll
            for (int i = 0; i < 4; ++i) { const int dd = nq - (16 * kb + 4 * g + i); const float dec = dd >= 0 ? __expf(lgf * (float)dd) : __expf(lgb * (float)(-dd)); pv[4 * hf + i] = sacc[i] * dec; }
        }
        pb[kt] = __builtin_bit_cast(bf16x8, pack8(pv));
        __builtin_amdgcn_sched_barrier(0);
    }
    f32x4 y[8];
    float sum = 0.f;
#pragma unroll
    for (int rb = 0; rb < 8; ++rb) {
        f32x4 ya = (f32x4){0.f, 0.f, 0.f, 0.f}, cf = ya, cbk = ya;
#pragma unroll
        for (int kt = 0; kt < 4; ++kt) {
            const bf16x4 v0 = *(const LAS bf16x4*)(rowp + 32768 + rb * 4096 + (((4 * kt + (g >> 1)) ^ fr) << 4) + 8 * (g & 1));
            const bf16x4 v1 = *(const LAS bf16x4*)(rowp + 32768 + rb * 4096 + (((4 * kt + 2 + (g >> 1)) ^ fr) << 4) + 8 * (g & 1));
            const bf16x8 va = __builtin_shufflevector(v0, v1, 0, 1, 2, 3, 4, 5, 6, 7); ya = MFMA16(va, pb[kt], ya); }
#pragma unroll
        for (int ks = 0; ks < 4; ++ks) { const int so = rb * 4096 + (((4 * ks + g) ^ fr) << 4);
            const bf16x8 af = *(const LAS bf16x8*)(rowp + 65536 + so), ab = *(const LAS bf16x8*)(rowp + 98304 + so);
            cf = MFMA16(af, bq[ks], cf); cbk = MFMA16(ab, bq[ks], cbk); }
        y[rb] = ya + cf * dq[0] + cbk * dq[1];
        sum += (y[rb][0] + y[rb][1]) + (y[rb][2] + y[rb][3]);
        __builtin_amdgcn_sched_barrier(0);
    }
    sum += __shfl_xor(sum, 16); sum += __shfl_xor(sum, 32);
    const float mu = sum * (1.f / 128.f);
    float var = 0.f;
#pragma unroll
    for (int rb = 0; rb < 8; ++rb) { y[rb] = y[rb] - mu; var += (y[rb][0] * y[rb][0] + y[rb][1] * y[rb][1]) + (y[rb][2] * y[rb][2] + y[rb][3] * y[rb][3]); }
    var += __shfl_xor(var, 16); var += __shfl_xor(var, 32);
    const float rstd = rsqrtf(var * (1.f / 128.f) + EPS);
    const bf16_t* gp = GR + tokq * 512 + h * 128 + 4 * g;
    const float* gn = (const float*)(ws + OFF_SM) + 64 + h * 128 + 4 * g;
#pragma unroll
    for (int rb = 0; rb < 8; ++rb) {
        const u32x2 gw = *(const u32x2*)(gp + 16 * rb); const f32x4 gg = *(const f32x4*)(gn + 16 * rb);
        const float v0 = y[rb][0] * rstd * gg[0] * bflo(gw.x), v1 = y[rb][1] * rstd * gg[1] * bfhi(gw.x), v2 = y[rb][2] * rstd * gg[2] * bflo(gw.y), v3 = y[rb][3] * rstd * gg[3] * bfhi(gw.y);
        u32x2 w; w.x = cvt_pk_bf16(v0, v1); w.y = cvt_pk_bf16(v2, v3);
        *(u32x2*)(qp + 16 * rb + 4 * g) = w;
    }
}


#define XB_TMO      128
#define XB_XCNT(j)  (256  + 64 * (j))
#define XB_XSUB(j)  (1280 + 64 * (j))
#define XB_XGEN(j)  (2304 + 64 * (j))
#define XB_TOP      3328
#define XB_TOPGEN   3392
#define XCD_BAR_WORDS 3456
#define XB_SPIN_CAP (1u << 22)
__device__ __forceinline__ unsigned xb_ld(unsigned* p)              { return __hip_atomic_load(p, __ATOMIC_RELAXED, __HIP_MEMORY_SCOPE_AGENT); }
__device__ __forceinline__ unsigned xb_add(unsigned* p, unsigned v) { return __hip_atomic_fetch_add(p, v, __ATOMIC_RELAXED, __HIP_MEMORY_SCOPE_AGENT); }
__device__ __forceinline__ unsigned xb_xcc_id() { return (unsigned)__builtin_amdgcn_s_getreg((3 << 11) | 20) & 0xFu; }
#define XB_SPIN(cond, bar) do { unsigned _sp = 0; while (cond) { __builtin_amdgcn_s_sleep(1); \
    if ((++_sp & 255u) == 0u) { if (xb_ld(&(bar)[XB_TMO])) break; if (_sp > XB_SPIN_CAP) { atomicAdd(&(bar)[XB_TMO], 1u); break; } } } } while (0)
struct XcdBarrier { unsigned* bar; unsigned x; volatile LAS unsigned* st; };
__device__ __forceinline__ XcdBarrier xcd_barrier_post(unsigned* bar, volatile LAS unsigned* st) {
    XcdBarrier b; b.bar = bar; b.x = xb_xcc_id(); b.st = st;
    if (threadIdx.x == 0) (void)xb_add(&bar[XB_XCNT(b.x)], 1u);
    return b;
}
__device__ __forceinline__ void xcd_barrier_complete(unsigned* bar, unsigned x, unsigned& nloc, unsigned& nx) {
    const unsigned G = gridDim.x * gridDim.y * gridDim.z;
    unsigned sum, cnt, mine, sp = 0u;
    for (;;) {
        sum = 0u; cnt = 0u; mine = 0u;
#pragma unroll
        for (unsigned j = 0; j < 16; ++j) { const unsigned c = xb_ld(&bar[XB_XCNT(j)]); sum += c; cnt += (c > 0u) ? 1u : 0u; mine = (j == x) ? c : mine; }
        if (sum == G) break;
        __builtin_amdgcn_s_sleep(1);
        if ((++sp & 255u) == 0u) { if (xb_ld(&bar[XB_TMO])) break; if (sp > XB_SPIN_CAP) { atomicAdd(&bar[XB_TMO], 1u); break; } }
    }
    nloc = mine > 0u ? mine : 1u; nx = cnt > 0u ? cnt : 1u;
}
__device__ __forceinline__ void xcd_barrier(const XcdBarrier& b) {
    asm volatile("s_waitcnt vmcnt(0)" ::: "memory");
    __syncthreads();
    if (threadIdx.x == 0) {
        unsigned* bar = b.bar;
        __builtin_amdgcn_s_waitcnt(0);
        unsigned nloc = b.st[0], nx = b.st[1];
        if (nloc == 0u) { xcd_barrier_complete(bar, b.x, nloc, nx); b.st[0] = nloc; b.st[1] = nx; }
        const unsigned old = xb_add(&bar[XB_XSUB(b.x)], 1u);
        const unsigned gen = old / nloc;
        if (old + 1u == (gen + 1u) * nloc) {
            __builtin_amdgcn_fence(__ATOMIC_RELEASE, "agent");
            asm volatile("s_waitcnt vmcnt(0)" ::: "memory");
            const unsigned og = xb_add(&bar[XB_TOP], 1u);
            const unsigned tg = og / nx;
            if (og + 1u == (tg + 1u) * nx) xb_add(&bar[XB_TOPGEN], 1u);
            else XB_SPIN(xb_ld(&bar[XB_TOPGEN]) == tg, bar);
            __builtin_amdgcn_fence(__ATOMIC_ACQUIRE, "agent");
            xb_add(&bar[XB_XGEN(b.x)], 1u);
            asm volatile("s_waitcnt vmcnt(0)" ::: "memory");
        } else {
            XB_SPIN(xb_ld(&bar[XB_XGEN(b.x)]) == gen, bar);
            __builtin_amdgcn_fence(__ATOMIC_ACQUIRE, "agent");
            asm volatile("s_waitcnt vmcnt(0)" ::: "memory");
        }
    }
    __syncthreads();
}

__global__ void __launch_bounds__(512, 2) fwd_megakernel(Params P) {
    extern __shared__ __attribute__((aligned(16))) unsigned char lds_raw[];
    LAS unsigned char* lds = (LAS unsigned char*)lds_raw;
    cg::grid_group grid = cg::this_grid();
    const int tid = threadIdx.x, G = gridDim.x;
#define LANE_ ((int)(threadIdx.x & 63))
#define WID_ (__builtin_amdgcn_readfirstlane((int)(threadIdx.x >> 6)))
    unsigned char* ws = P.ws;
    float* ss = (float*)(ws + OFF_SS);
    bf16_t* XB = (bf16_t*)(ws + OFF_XB); bf16_t* H = (bf16_t*)(ws + OFF_BIG);
    pg8::StaticOrder S;

#define GSYNC() do { asm volatile("s_waitcnt vmcnt(0) lgkmcnt(0)" ::: "memory"); __syncthreads(); grid.sync(); \
        __builtin_amdgcn_fence(__ATOMIC_ACQUIRE, "agent"); asm volatile("s_waitcnt vmcnt(0)" ::: "memory"); __syncthreads(); } while (0)
    volatile LAS unsigned* bst = (volatile LAS unsigned*)(lds + 131072);
    if (tid < 4) bst[tid] = 0u;
    __syncthreads();
    XcdBarrier xbar = xcd_barrier_post((unsigned*)(ws + OFF_BARW), bst);
    if (P.ws == nullptr) GSYNC();
#undef GSYNC
#define GSYNC() xcd_barrier(xbar)
    p0_prologue(P, lds, WID_, LANE_);
    GSYNC();
    { pg8::Gemm g{XB, (const bf16_t*)(ws + OFF_W1T), T, NFF2, D}; S.init(T, NFF2, G, blockIdx.x); EpiSwiglu E{ws, 0}; pg8::gemm_phase(lds, g, S, E); }
    GSYNC();
    { pg8::Gemm g{H, (const bf16_t*)(ws + OFF_W1O), T, D, FFP}; S.init(T, D, G, blockIdx.x); EpiResid<false> E{nullptr, ws, 1, 0.5f}; pg8::gemm_phase(lds, g, S, E); }
    GSYNC();
    { pg8::Gemm g{XB, (const bf16_t*)(ws + OFF_WIN), T, NIN, D}; pg8::TailSplitOrder TS; TS.S.init(T, NIN, G, blockIdx.x);
      EpiProj E{ws};
      pg8::gemm_phase(lds, g, TS, E); }
    GSYNC();
    for (int u = blockIdx.x; u < 768; u += G) { if (u < 512) attn_unit(ws, lds, u, WID_, LANE_); else r12_unit(ws, (bf16_t*)P.out, lds, u - 512, WID_, LANE_); }
    asm volatile("s_waitcnt vmcnt(0)" ::: "memory"); __syncthreads();
    GSYNC();
    for (int u = blockIdx.x; u < 1024; u += G) r3_unit(ws, (const bf16_t*)P.out, lds, u, WID_, LANE_);
    asm volatile("s_waitcnt vmcnt(0)" ::: "memory"); __syncthreads();
    GSYNC();
    { pg8::PairOrder PO; PO.S.init(T, D, G, blockIdx.x);
      pg8::Gemm g{(const bf16_t*)(ws + OFF_QR), (const bf16_t*)(ws + OFF_WRET), T, D, 512, (const bf16_t*)(ws + OFF_QA), (const bf16_t*)(ws + OFF_WATT)};
      EpiGate E{ws}; pg8::gemm_phase(lds, g, PO, E); }
    GSYNC();
    { pg8::Gemm g{(const bf16_t*)(ws + OFF_MG), (const bf16_t*)(ws + OFF_WOUT), T, D, D}; S.init(T, D, G, blockIdx.x); EpiResid<false> E{nullptr, ws, 2, 1.0f}; pg8::gemm_phase(lds, g, S, E); }
    GSYNC();
    { pg8::Gemm g{XB, (const bf16_t*)(ws + OFF_W2T), T, NFF2, D}; S.init(T, NFF2, G, blockIdx.x); EpiSwiglu E{ws, 2}; pg8::gemm_phase(lds, g, S, E); }
    GSYNC();
    { pg8::Gemm g{H, (const bf16_t*)(ws + OFF_W2O), T, D, FFP}; S.init(T, D, G, blockIdx.x); EpiResid<false> E{nullptr, ws, 3, 0.5f}; pg8::gemm_phase(lds, g, S, E); }
    GSYNC();
    int lane9 = threadIdx.x & 63; asm volatile("" : "+v"(lane9));
    {
        const f32x4* gf = (const f32x4*)P.gfin + lane9;
        for (int row0 = blockIdx.x * 8 + WID_; row0 < T; row0 += G * 32) {
            u32x2 w[4][4]; float rs4[4];
#pragma unroll
            for (int r = 0; r < 4; ++r) { const int row = row0 + r * G * 8; rs4[r] = ss[3 * T + row]; const u32x2* xr = (const u32x2*)(XB + (size_t)row * D) + lane9;
#pragma unroll
                for (int j = 0; j < 4; ++j) w[r][j] = xr[64 * j]; }
            f32x4 gg[4];
#pragma unroll
            for (int j = 0; j < 4; ++j) gg[j] = gf[64 * j];
#pragma unroll
            for (int r = 0; r < 4; ++r) { const int row = row0 + r * G * 8; const float rstd = rsqrtf(rs4[r] * (1.f / 1024.f) + EPS); f32x4* o = (f32x4*)(P.out + (size_t)row * D) + lane9;
#pragma unroll
                for (int j = 0; j < 4; ++j) o[64 * j] = (f32x4){bflo(w[r][j].x), bfhi(w[r][j].x), bflo(w[r][j].y), bfhi(w[r][j].y)} * rstd * gg[j]; }
        }
    }
}

extern "C" void kernel_launch(void* const* d_in, const int* in_sizes, int n_in, void* d_out, int out_size, void* d_ws, size_t ws_size, hipStream_t stream) {
    constexpr int LDS_BYTES = pg8::STAGE_BYTES + 256;
    static int grid = 0;
    if (grid == 0) {
        if (n_in != 17 || in_sizes[0] != T * D || out_size != T * D || ws_size < WS_END) { fprintf(stderr, "kernel_launch: unexpected shapes (n_in %d, in0 %d, out %d, ws %zu < %zu)\n", n_in, n_in > 0 ? in_sizes[0] : -1, out_size, ws_size, (size_t)WS_END); grid = -1; return; }
        int dev = 0, cus = 0, per_cu = 0;
        (void)hipGetDevice(&dev);
        (void)hipDeviceGetAttribute(&cus, hipDeviceAttributeMultiprocessorCount, dev);
        if (hipFuncSetAttribute((const void*)fwd_megakernel, hipFuncAttributeMaxDynamicSharedMemorySize, LDS_BYTES) != hipSuccess) { fprintf(stderr, "kernel_launch: hipFuncSetAttribute failed\n"); grid = -1; return; }
        if (hipOccupancyMaxActiveBlocksPerMultiprocessor(&per_cu, (const void*)fwd_megakernel, 512, LDS_BYTES) != hipSuccess || per_cu < 1) { fprintf(stderr, "kernel_launch: occupancy query failed (%d)\n", per_cu); (void)hipGetLastError(); per_cu = 1; }
        grid = cus * per_cu;
        if (grid > 2048) grid = 2048;
    }
    if (grid < 0) return;
    if (hipMemsetAsync((char*)d_ws + OFF_BARW, 0, 16384, stream) != hipSuccess) { fprintf(stderr, "kernel_launch: memset of the barrier words failed\n"); return; }
    Params p{};
    p.x = (const float*)d_in[0]; p.g1 = (const float*)d_in[1]; p.w1i = (const float*)d_in[2]; p.w1o = (const float*)d_in[3]; p.gmix = (const float*)d_in[4]; p.win = (const float*)d_in[5];
    p.dfw = (const float*)d_in[6]; p.dbw = (const float*)d_in[7]; p.gng = (const float*)d_in[8]; p.wret = (const float*)d_in[9]; p.sink = (const float*)d_in[10]; p.watt = (const float*)d_in[11];
    p.wout = (const float*)d_in[12]; p.g2 = (const float*)d_in[13]; p.w2i = (const float*)d_in[14]; p.w2o = (const float*)d_in[15]; p.gfin = (const float*)d_in[16];
    p.out = (float*)d_out; p.ws = (unsigned char*)d_ws;
    void* args[] = {&p};
    hipError_t e = hipLaunchCooperativeKernel((const void*)fwd_megakernel, dim3(grid), dim3(512), args, LDS_BYTES, stream);
    if (e != hipSuccess) fprintf(stderr, "cooperative launch failed: %s (grid %d)\n", hipGetErrorString(e), grid);
}
```

```cpp
#include <hip/hip_runtime.h>
#include <hip/hip_cooperative_groups.h>
#include <cstdio>
#include <cstdint>
namespace cg = cooperative_groups;

#define LAS __attribute__((address_space(3)))
typedef unsigned short bf16_t;
typedef short bf16x8 __attribute__((ext_vector_type(8)));
typedef short bf16x4 __attribute__((ext_vector_type(4)));
typedef float f32x4 __attribute__((ext_vector_type(4)));
typedef float f32x2 __attribute__((ext_vector_type(2)));
typedef unsigned u32x4 __attribute__((ext_vector_type(4)));
typedef unsigned u32x2 __attribute__((ext_vector_type(2)));

constexpr int T = 32768, D = 1024, FF = 2752, FFP = 2816, NFF2 = 5632, NIN = 4864, SEQ = 4096;
constexpr float EPS = 1e-6f;

constexpr size_t MiB = 1u << 20;
constexpr size_t OFF_W1T = 0;
constexpr size_t OFF_W2T = 11 * MiB;
constexpr size_t OFF_W1O = 22 * MiB;
constexpr size_t OFF_W2O = OFF_W1O + 5767168;
constexpr size_t OFF_WIN = 33 * MiB;
constexpr size_t OFF_WRET = OFF_WIN + 9961472;
constexpr size_t OFF_WATT = OFF_WRET + 1 * MiB;
constexpr size_t OFF_WOUT = OFF_WATT + 1 * MiB;
constexpr size_t OFF_TABR = OFF_WOUT + 2 * MiB;
constexpr size_t OFF_TABA = OFF_TABR + 2 * MiB;
constexpr size_t OFF_DT = OFF_TABA + 1 * MiB;
constexpr size_t OFF_SM = OFF_DT + 16384;
constexpr size_t OFF_SS = OFF_DT + 65536;
constexpr size_t OFF_XB = 51 * MiB;
constexpr size_t OFF_BIG = 115 * MiB;
constexpr size_t OFF_QR = OFF_BIG;
constexpr size_t OFF_KR = OFF_QR + 32 * MiB;
constexpr size_t OFF_KFT = OFF_KR + 32 * MiB;
constexpr size_t OFF_KBT = OFF_KFT + 32 * MiB;
constexpr size_t OFF_VRT = OFF_KBT + 32 * MiB;
constexpr size_t OFF_GR = OFF_VRT + 32 * MiB;
constexpr size_t OFF_QA = OFF_GR + 32 * MiB;
constexpr size_t OFF_KA = OFF_QA + 32 * MiB;
constexpr size_t OFF_VAT = OFF_KA + 8 * MiB;
constexpr size_t OFF_SR = OFF_VAT + 8 * MiB;
constexpr size_t OFF_SA = OFF_SR + 64 * MiB;
constexpr size_t OFF_MG = OFF_KR;
constexpr size_t OFF_BARW = OFF_SA + 64 * MiB;
constexpr size_t WS_END = OFF_BARW + 16384;
static_assert(OFF_SS + 4 * T * 4 <= OFF_XB, "ws map");
static_assert(OFF_BIG + (size_t)T * FFP * 2 <= WS_END, "ws map H");

struct Params {
    const float* x; const float* g1; const float* w1i; const float* w1o; const float* gmix; const float* win;
    const float* dfw; const float* dbw; const float* gng; const float* wret; const float* sink; const float* watt;
    const float* wout; const float* g2; const float* w2i; const float* w2o; const float* gfin;
    float* out; unsigned char* ws;
};

typedef __bf16 bf16v2_t __attribute__((ext_vector_type(2)));
__device__ __forceinline__ unsigned cvt_pk_bf16(float lo, float hi) { const f32x2 v = {lo, hi}; const bf16v2_t r = __builtin_convertvector(v, bf16v2_t); return __builtin_bit_cast(unsigned, r); }
__device__ __forceinline__ float bf2f(unsigned short b) { return __uint_as_float(((unsigned)b) << 16); }
__device__ __forceinline__ float bflo(unsigned w) { return __uint_as_float(w << 16); }
__device__ __forceinline__ float bfhi(unsigned w) { return __uint_as_float(w & 0xffff0000u); }
__device__ __forceinline__ unsigned short f2bf(float f) { unsigned u = __float_as_uint(f); return (unsigned short)((u + 0x7fffu + ((u >> 16) & 1u)) >> 16); }
__device__ __forceinline__ float sigm(float v) { return __builtin_amdgcn_rcpf(1.f + __expf(-v)); }
__device__ __forceinline__ u32x4 pack8(const float* v) { u32x4 w; w.x = cvt_pk_bf16(v[0], v[1]); w.y = cvt_pk_bf16(v[2], v[3]); w.z = cvt_pk_bf16(v[4], v[5]); w.w = cvt_pk_bf16(v[6], v[7]); return w; }
#define MFMA16(a, b, c) __builtin_amdgcn_mfma_f32_16x16x32_bf16((a), (b), (c), 0, 0, 0)

namespace pg8 {
constexpr int BM = 256, BK = 64, HALF = 128, HTB = HALF * BK * 2, STAGE_BYTES = 8 * HTB, NXCD = 8, WGM = 8;
__host__ __device__ __forceinline__ int lds_byte(int r, int c) { const int st = (r >> 4) * 2 + (c >> 5), rr = r & 15, cc = c & 31, ob = rr * 64 + cc * 2; return st * 1024 + (ob ^ (((ob >> 9) & 1) << 5)); }
__host__ __device__ __forceinline__ void stage_rc(int b, int& R, int& C) { const int st = b / 1024, sb = b % 1024, swz = sb ^ (((sb >> 9) & 1) << 5); R = (st >> 1) * 16 + swz / 64; C = (st & 1) * 32 + (swz % 64) / 2; }
__host__ __device__ __forceinline__ int perm32(int rho) { const int n = rho >> 4, i = rho & 15; return 8 * (i >> 2) + 4 * n + (i & 3); }

struct Unit { int pm, pn, hsel, half, which; };
struct Gemm { const bf16_t* A; const bf16_t* Bt; int M, N, K; const bf16_t* A2; const bf16_t* Bt2; };

struct StaticOrder {
    int nM, nN, nwg, G, c;
    __host__ __device__ void init(int M, int N, int G_, int c_) { nM = M / BM; nN = N / BM; nwg = nM * nN; G = G_; c = c_; }
    __host__ __device__ bool next(int i, Unit& u) const {
        const long L = (long)i * G + c; if (L >= nwg) return false;
        int wgid = (int)L; { const int q = nwg / NXCD, r = nwg % NXCD, xcd = wgid % NXCD, off = wgid / NXCD; wgid = (xcd < r ? xcd * (q + 1) : r * (q + 1) + (xcd - r) * q) + off; }
        const int nig = WGM * nN, gid = wgid / nig, fm = gid * WGM, gsz = (nM - fm) < WGM ? (nM - fm) : WGM;
        u.pm = fm + ((wgid % nig) % gsz); u.pn = (wgid % nig) / gsz; u.hsel = 0; u.half = 0; u.which = 0; return true;
    }
};

struct PairOrder {
    StaticOrder S;
    __host__ __device__ bool next(int i, Unit& u) const { if (!S.next(i >> 1, u)) return false; u.which = i & 1; return true; }
};

struct TailSplitOrder {
    StaticOrder S;
    __host__ __device__ bool next(int i, Unit& u) const {
        const int full = S.nwg / S.G, rem = S.nwg - full * S.G;
        if (i < full || 2 * rem != S.G) return S.next(i, u);
        if (i > full) return false;
        StaticOrder S2 = S; S2.c = S.c % rem;
        if (!S2.next(full, u)) return false;
        u.hsel = S.c / rem; u.half = 1; return true;
    }
};

template <class Epi, class Order>
__device__ __forceinline__ void gemm_phase(LAS unsigned char* lds, const Gemm g, const Order& S, const Epi& E) {
    int tid = threadIdx.x; asm volatile("" : "+v"(tid));
    const int wid = __builtin_amdgcn_readfirstlane(tid >> 6), lane = tid & 63, wr = wid >> 2, wc = wid & 3, fr = lane & 15, fq = lane >> 4;
    const int K = g.K, nt = K / BK;
    unsigned voffA[2], voffB[2];
#pragma unroll
    for (int i = 0; i < 2; ++i) { int R, C; stage_rc(tid * 16 + i * 8192, R, C); const int Rb = (R & ~31) + perm32(R & 31);
        voffA[i] = (unsigned)(R * K + C) * 2u; voffB[i] = (unsigned)(Rb * K + C) * 2u; }
    const size_t kstep = (size_t)(BK * 2);
    const size_t hstep = (size_t)HALF * K * 2;
    const size_t tstep = 2 * hstep;
    const unsigned ldsw = (unsigned)wid * 1024u;
    const int aoff = lds_byte(wr * 64 + fr, fq * 8), boff = lds_byte(wc * 32 + fr, fq * 8);
#define PG8_SA(b, h) (((b) * 2 + (h)) * HTB)
#define PG8_SB(b, h) ((4 + (b) * 2 + (h)) * HTB)
#define PG8_STAGE(bufoff, gbase, voff) do { _Pragma("unroll") for (int _i = 0; _i < 2; ++_i) \
        __builtin_amdgcn_global_load_lds((const unsigned*)((const char*)(gbase) + (voff)[_i]), (LAS unsigned*)(lds + (bufoff) + ldsw + _i * 8192), 16, 0, 0); } while (0)
#define PG8_LDA(dst, b, h) do { _Pragma("unroll") for (int m = 0; m < 4; ++m) _Pragma("unroll") for (int k = 0; k < 2; ++k) dst[m][k] = *(const LAS bf16x8*)(lds + PG8_SA(b, h) + aoff + m * 2048 + k * 1024); } while (0)
#define PG8_LDB(dst, b, h) do { _Pragma("unroll") for (int n = 0; n < 2; ++n) _Pragma("unroll") for (int k = 0; k < 2; ++k) dst[n][k] = *(const LAS bf16x8*)(lds + PG8_SB(b, h) + boff + n * 2048 + k * 1024); } while (0)
#define PG8_MMA(ai, bj, At, Bt) do { __builtin_amdgcn_s_setprio(1); _Pragma("unroll") for (int m = 0; m < 4; ++m) _Pragma("unroll") for (int n = 0; n < 2; ++n) _Pragma("unroll") for (int k = 0; k < 2; ++k) \
        acc[ai][bj][m][n] = __builtin_amdgcn_mfma_f32_16x16x32_bf16(Bt[n][k], At[m][k], acc[ai][bj][m][n], 0, 0, 0); __builtin_amdgcn_s_setprio(0); } while (0)
#define PG8_WAIT_V(n) asm volatile("s_waitcnt vmcnt(" #n ")" ::: "memory")
#define PG8_WAIT_L(n) asm volatile("s_waitcnt lgkmcnt(" #n ")" ::: "memory")
#define PG8_BAR __builtin_amdgcn_s_barrier()
#define PG8_SCHED __builtin_amdgcn_sched_barrier(0)
    Unit cur, nxt; int ui = 0;
    if (!S.next(0, cur)) return;
    f32x4 acc[2][2][4][2];
#pragma unroll
    for (int a = 0; a < 2; ++a)
#pragma unroll
        for (int b = 0; b < 2; ++b)
#pragma unroll
            for (int m = 0; m < 4; ++m)
#pragma unroll
                for (int n = 0; n < 2; ++n) acc[a][b][m][n] = (f32x4){0.f, 0.f, 0.f, 0.f};
    bf16x8 At[4][2], B0[2][2], B1[2][2];
    const char* cA = (const char*)(cur.which ? g.A2 : g.A) + (size_t)cur.pm * tstep + (size_t)cur.hsel * hstep; const char* cB = (const char*)(cur.which ? g.Bt2 : g.Bt) + (size_t)cur.pn * tstep;
    PG8_STAGE(PG8_SB(0, 0), cB, voffB); PG8_STAGE(PG8_SB(0, 1), cB + hstep, voffB); PG8_STAGE(PG8_SA(0, 0), cA, voffA); PG8_STAGE(PG8_SA(0, 1), cA + hstep, voffA);
    if (wr == 1) PG8_BAR;
    PG8_WAIT_V(2); PG8_BAR;
    PG8_STAGE(PG8_SB(1, 0), cB + kstep, voffB); PG8_STAGE(PG8_SA(1, 0), cA + kstep, voffA); PG8_STAGE(PG8_SB(1, 1), cB + hstep + kstep, voffB);
    PG8_WAIT_V(6); PG8_BAR;
    for (;;) {
        const bool has_next = S.next(ui + 1, nxt);
        const char* nA = has_next ? (const char*)(nxt.which ? g.A2 : g.A) + (size_t)nxt.pm * tstep + (size_t)nxt.hsel * hstep : cA; const char* nB = has_next ? (const char*)(nxt.which ? g.Bt2 : g.Bt) + (size_t)nxt.pn * tstep : cB;
        for (int t = 0; t < nt; t += 2) {
            const bool last = (t == nt - 2);
            const char* a1 = cA + (size_t)(t + 1) * kstep;
            const char* a2 = last ? nA : cA + (size_t)(t + 2) * kstep; const char* b2 = last ? nB : cB + (size_t)(t + 2) * kstep;
            const char* a3 = a2 + kstep; const char* b3 = b2 + kstep;
            PG8_LDB(B0, 0, 0); PG8_LDB(B1, 0, 1); PG8_SCHED; PG8_LDA(At, 0, 0); PG8_STAGE(PG8_SA(1, 1), a1 + hstep, voffA);
            PG8_WAIT_V(8); PG8_WAIT_L(0); PG8_BAR; PG8_MMA(0, 0, At, B0); PG8_MMA(0, 1, At, B1); PG8_BAR; PG8_SCHED;
            PG8_LDA(At, 0, 1); PG8_STAGE(PG8_SB(0, 0), b2, voffB); PG8_STAGE(PG8_SB(0, 1), b2 + hstep, voffB); PG8_STAGE(PG8_SA(0, 0), a2, voffA);
            PG8_WAIT_V(8); PG8_WAIT_L(0); PG8_BAR; if (!cur.half) { PG8_MMA(1, 0, At, B0); PG8_MMA(1, 1, At, B1); } PG8_BAR; PG8_SCHED;
            PG8_LDB(B0, 1, 0); PG8_LDB(B1, 1, 1); PG8_SCHED; PG8_LDA(At, 1, 0); PG8_STAGE(PG8_SA(0, 1), a2 + hstep, voffA);
            PG8_WAIT_V(8); PG8_WAIT_L(0); PG8_BAR; PG8_MMA(0, 0, At, B0); PG8_MMA(0, 1, At, B1); PG8_BAR; PG8_SCHED;
            PG8_LDA(At, 1, 1); PG8_STAGE(PG8_SB(1, 0), b3, voffB); PG8_STAGE(PG8_SB(1, 1), b3 + hstep, voffB); PG8_STAGE(PG8_SA(1, 0), a3, voffA);
            PG8_WAIT_V(8); PG8_WAIT_L(0); PG8_BAR; if (!cur.half) { PG8_MMA(1, 0, At, B0); PG8_MMA(1, 1, At, B1); } PG8_BAR; PG8_SCHED;
        }
        if (wr == 0) PG8_BAR;
        bool keep = false;
        if constexpr (Epi::FUSE_PAIR) { if (cur.which == 0) { E.mid(acc, cur, wr, wc, fr, fq); keep = true; } else E(acc, cur, wr, wc, fr, fq); }
        else E(acc, cur, wr, wc, fr, fq);
        if (!has_next) break;
        if (!keep) {
#pragma unroll
        for (int a = 0; a < 2; ++a)
#pragma unroll
            for (int b = 0; b < 2; ++b)
#pragma unroll
                for (int m = 0; m < 4; ++m)
#pragma unroll
                    for (int n = 0; n < 2; ++n) acc[a][b][m][n] = (f32x4){0.f, 0.f, 0.f, 0.f};
        }
        cur = nxt; cA = nA; cB = nB; ++ui;
        if (wr == 1) PG8_BAR;
    }
    PG8_WAIT_V(0);
    PG8_BAR;
#undef PG8_SA
#undef PG8_SB
#undef PG8_STAGE
#undef PG8_LDA
#undef PG8_LDB
#undef PG8_MMA
#undef PG8_WAIT_V
#undef PG8_WAIT_L
#undef PG8_BAR
#undef PG8_SCHED
}
}
using pg8::Unit;

#define ACC_T const f32x4 (&acc)[2][2][4][2]

struct EpiSwiglu {
    static constexpr bool FUSE_PAIR = false;
    unsigned char* ws; int ssi;
    __device__ __forceinline__ void operator()(ACC_T, const Unit& u, int wr, int wc, int fr, int fq) const {
        const int p0 = wc * 32 + 8 * fq;
        bf16_t* H = (bf16_t*)(ws + OFF_BIG); const float* ss = (const float*)(ws + OFF_SS) + (size_t)ssi * T;
        float rs[8];
#pragma unroll
        for (int i = 0; i < 8; ++i) rs[i] = ss[u.pm * 256 + (i >> 2) * 128 + wr * 64 + (i & 3) * 16 + fr];
#pragma unroll
        for (int ai = 0; ai < 2; ++ai)
#pragma unroll
            for (int m = 0; m < 4; ++m) {
                const int row = u.pm * 256 + ai * 128 + wr * 64 + m * 16 + fr;
                const float rstd = rsqrtf(rs[ai * 4 + m] * (1.f / 1024.f) + EPS);
                float h[8];
#pragma unroll
                for (int n = 0; n < 2; ++n)
#pragma unroll
                    for (int e = 0; e < 4; ++e) { const float gv = acc[ai][0][m][n][e] * rstd, uv = acc[ai][1][m][n][e] * rstd; h[4 * n + e] = gv * sigm(gv) * uv; }
                __builtin_nontemporal_store(pack8(h), (u32x4*)(H + (size_t)row * FFP + u.pn * 128 + p0));
            }
    }
};

template <bool BASE_F32> struct EpiResid {
    static constexpr bool FUSE_PAIR = false;
    const float* basef; unsigned char* ws; int ssi; float scale;
    __device__ __forceinline__ void operator()(ACC_T, const Unit& u, int wr, int wc, int fr, int fq) const {
        const int p0 = wc * 32 + 8 * fq;
        bf16_t* xb = (bf16_t*)(ws + OFF_XB); float* ss = (float*)(ws + OFF_SS) + (size_t)ssi * T;
#pragma unroll
        for (int ai = 0; ai < 2; ++ai) {
            f32x4 bb[4][2][2];
#pragma unroll
            for (int m = 0; m < 4; ++m)
#pragma unroll
                for (int bj = 0; bj < 2; ++bj) { const size_t off = (size_t)(u.pm * 256 + ai * 128 + wr * 64 + m * 16 + fr) * D + u.pn * 256 + bj * 128 + p0;
                    if (BASE_F32) { bb[m][bj][0] = *(const f32x4*)(basef + off); bb[m][bj][1] = *(const f32x4*)(basef + off + 4); }
                    else { const u32x4 bw = *(const u32x4*)(xb + off); bb[m][bj][0] = __builtin_bit_cast(f32x4, bw); } }
            float sqm[4];
#pragma unroll
            for (int m = 0; m < 4; ++m) {
                const int row = u.pm * 256 + ai * 128 + wr * 64 + m * 16 + fr;
                float sq = 0.f;
#pragma unroll
                for (int bj = 0; bj < 2; ++bj) {
                    const size_t off = (size_t)row * D + u.pn * 256 + bj * 128 + p0;
                    f32x4 b0, b1;
                    if (BASE_F32) { b0 = bb[m][bj][0]; b1 = bb[m][bj][1]; }
                    else { const u32x4 bw = __builtin_bit_cast(u32x4, bb[m][bj][0]); b0 = (f32x4){bflo(bw.x), bfhi(bw.x), bflo(bw.y), bfhi(bw.y)}; b1 = (f32x4){bflo(bw.z), bfhi(bw.z), bflo(bw.w), bfhi(bw.w)}; }
                    const f32x4 o0 = b0 + acc[ai][bj][m][0] * scale, o1 = b1 + acc[ai][bj][m][1] * scale;
                    sq += (o0[0] * o0[0] + o0[1] * o0[1]) + (o0[2] * o0[2] + o0[3] * o0[3]) + (o1[0] * o1[0] + o1[1] * o1[1]) + (o1[2] * o1[2] + o1[3] * o1[3]);
                    u32x4 w; w.x = cvt_pk_bf16(o0[0], o0[1]); w.y = cvt_pk_bf16(o0[2], o0[3]); w.z = cvt_pk_bf16(o1[0], o1[1]); w.w = cvt_pk_bf16(o1[2], o1[3]); *(u32x4*)(xb + off) = w;
                }
                sq += __shfl_xor(sq, 16); sq += __shfl_xor(sq, 32);
                sqm[m] = sq;
            }
            const float v = fq == 0 ? sqm[0] : fq == 1 ? sqm[1] : fq == 2 ? sqm[2] : sqm[3];
            atomicAdd(ss + (u.pm * 256 + ai * 128 + wr * 64 + fq * 16 + fr), v);
        }
    }
};

struct EpiGate {
    static constexpr bool FUSE_PAIR = true;
    unsigned char* ws;
    __device__ __forceinline__ void mid(f32x4 (&acc)[2][2][4][2], const Unit& u, int wr, int wc, int fr, int fq) const {
        asm volatile("" : "+v"(fr), "+v"(fq));
        const int p0 = wc * 32 + 8 * fq;
        const unsigned char* gr = (const unsigned char*)(ws + OFF_SR); const unsigned char* ga = (const unsigned char*)(ws + OFF_SA);
#pragma unroll
        for (int ai = 0; ai < 2; ++ai) {
            u32x2 rv[4][2], av[4][2];
#pragma unroll
            for (int m = 0; m < 4; ++m)
#pragma unroll
                for (int bj = 0; bj < 2; ++bj) { const int off = (u.pm * 256 + ai * 128 + wr * 64 + m * 16 + fr) * D + u.pn * 256 + bj * 128 + p0;
                    rv[m][bj] = *(const u32x2*)(gr + off); av[m][bj] = *(const u32x2*)(ga + off); }
#pragma unroll
            for (int m = 0; m < 4; ++m)
#pragma unroll
                for (int bj = 0; bj < 2; ++bj) {
                    const u32x2 r = rv[m][bj], a = av[m][bj];
#pragma unroll
                    for (int e = 0; e < 4; ++e) {
                        acc[ai][bj][m][0][e] *= (float)((r.x >> (8 * e)) & 0xffu) * __builtin_amdgcn_rcpf((float)((a.x >> (8 * e)) & 0xffu));
                        acc[ai][bj][m][1][e] *= (float)((r.y >> (8 * e)) & 0xffu) * __builtin_amdgcn_rcpf((float)((a.y >> (8 * e)) & 0xffu)); }
                }
        }
    }
    __device__ __forceinline__ void operator()(ACC_T, const Unit& u, int wr, int wc, int fr, int fq) const {
        asm volatile("" : "+v"(fr), "+v"(fq));
        const int p0 = wc * 32 + 8 * fq;
        bf16_t* MG = (bf16_t*)(ws + OFF_MG); const unsigned char* ga = (const unsigned char*)(ws + OFF_SA);
#pragma unroll
        for (int ai = 0; ai < 2; ++ai) {
            u32x2 av[4][2];
#pragma unroll
            for (int m = 0; m < 4; ++m)
#pragma unroll
                for (int bj = 0; bj < 2; ++bj) av[m][bj] = *(const u32x2*)(ga + (u.pm * 256 + ai * 128 + wr * 64 + m * 16 + fr) * D + u.pn * 256 + bj * 128 + p0);
#pragma unroll
            for (int m = 0; m < 4; ++m)
#pragma unroll
                for (int bj = 0; bj < 2; ++bj) {
                    const int off = (u.pm * 256 + ai * 128 + wr * 64 + m * 16 + fr) * D + u.pn * 256 + bj * 128 + p0;
                    const u32x2 a = av[m][bj]; const float q = 1.f / 255.f;
                    float v[8];
#pragma unroll
                    for (int e = 0; e < 4; ++e) { v[e] = acc[ai][bj][m][0][e] * ((float)((a.x >> (8 * e)) & 0xffu) * q); v[4 + e] = acc[ai][bj][m][1][e] * ((float)((a.y >> (8 * e)) & 0xffu) * q); }
                    *(u32x4*)(MG + off) = pack8(v);
                }
        }
    }
};

struct EpiProj {
    static constexpr bool FUSE_PAIR = false;
    unsigned char* ws;
    __device__ __forceinline__ void operator()(ACC_T, const Unit& u, int wr, int wc, int fr, int fq) const {
        asm volatile("" : "+v"(fr), "+v"(fq));
        const int pn = u.pn, p0 = wc * 32 + 8 * fq;
        const float* ss = (const float*)(ws + OFF_SS) + T; const f32x4* tabR = (const f32x4*)(ws + OFF_TABR); const f32x4* tabA = (const f32x4*)(ws + OFF_TABA); const f32x4* dt = (const f32x4*)(ws + OFF_DT);
        bf16_t *QR = (bf16_t*)(ws + OFF_QR), *KR = (bf16_t*)(ws + OFF_KR), *KFT = (bf16_t*)(ws + OFF_KFT), *KBT = (bf16_t*)(ws + OFF_KBT), *VRT = (bf16_t*)(ws + OFF_VRT), *GR = (bf16_t*)(ws + OFF_GR),
               *QA = (bf16_t*)(ws + OFF_QA), *KA = (bf16_t*)(ws + OFF_KA), *VAT = (bf16_t*)(ws + OFF_VAT), *SR = (bf16_t*)(ws + OFF_SR), *SA = (bf16_t*)(ws + OFF_SA);
        const int rbase = u.pm * 256 + u.hsel * 128 + wr * 64 + fr;
        float rs[8];
#pragma unroll
        for (int i = 0; i < 8; ++i) rs[i] = ss[rbase + (i >> 2) * 128 + (i & 3) * 16];
        const bool ropeR = pn < 4, ropeA = (pn >= 8 && pn < 10) || (pn == 10 && wc < 2);
        f32x4 tn[4];
        if (ropeR || ropeA) { const int s0 = rbase & (SEQ - 1); const f32x4* tp0 = ropeR ? tabR + ((size_t)s0 * 64 + (p0 & 63)) / 2 : tabA + ((size_t)s0 * 32 + (p0 & 31)) / 2;
#pragma unroll
            for (int q = 0; q < 4; ++q) tn[q] = tp0[q]; }
#pragma unroll
        for (int ai = 0; ai < 2; ++ai)
#pragma unroll
            for (int m = 0; m < 4; ++m) {
                if (ai == 1 && u.half) continue;
                const int row = rbase + ai * 128 + m * 16;
                const float rstd = rsqrtf(rs[ai * 4 + m] * (1.f / 1024.f) + EPS);
                const int s = row & (SEQ - 1), b = row >> 12;
                f32x4 tc[4];
#pragma unroll
                for (int q = 0; q < 4; ++q) tc[q] = tn[q];
                if ((ropeR || ropeA) && (ai * 4 + m) < 7) { const int i1 = ai * 4 + m + 1; const int s1 = (rbase + (i1 >> 2) * 128 + (i1 & 3) * 16) & (SEQ - 1);
                    const f32x4* tp1 = ropeR ? tabR + ((size_t)s1 * 64 + (p0 & 63)) / 2 : tabA + ((size_t)s1 * 32 + (p0 & 31)) / 2;
#pragma unroll
                    for (int q = 0; q < 4; ++q) tn[q] = tp1[q]; }
                float lo[8], hi[8];
#pragma unroll
                for (int e = 0; e < 4; ++e) { lo[e] = acc[ai][0][m][0][e] * rstd; lo[4 + e] = acc[ai][0][m][1][e] * rstd; hi[e] = acc[ai][1][m][0][e] * rstd; hi[4 + e] = acc[ai][1][m][1][e] * rstd; }
                if (pn < 4) {
                    const int head = 2 * (pn & 1) + (p0 >> 6), j0 = p0 & 63;
                    float o1[8], o2[8];
#pragma unroll
                    for (int q = 0; q < 4; ++q) { const f32x4 cs = tc[q];
                        o1[2 * q] = lo[2 * q] * cs[0] - hi[2 * q] * cs[1]; o2[2 * q] = lo[2 * q] * cs[1] + hi[2 * q] * cs[0];
                        o1[2 * q + 1] = lo[2 * q + 1] * cs[2] - hi[2 * q + 1] * cs[3]; o2[2 * q + 1] = lo[2 * q + 1] * cs[3] + hi[2 * q + 1] * cs[2]; }
                    if (pn < 2) {
                        bf16_t* qp = QR + (size_t)row * 512 + head * 128 + j0;
                        *(u32x4*)qp = pack8(o1); *(u32x4*)(qp + 64) = pack8(o2);
                    } else {
                        const float ksc = 0.08838834764831845f;
#pragma unroll
                        for (int e = 0; e < 8; ++e) { o1[e] *= ksc; o2[e] *= ksc; }
                        bf16_t* kp = KR + (((size_t)(b * 4 + head) * 32 + (s >> 7)) * 128 + (s & 127)) * 128;
                        *(u32x4*)(kp + (((j0 >> 3) ^ (s & 15)) << 3)) = pack8(o1); *(u32x4*)(kp + ((((j0 >> 3) + 8) ^ (s & 15)) << 3)) = pack8(o2);
                        const f32x4 dd = dt[head * 128 + (s & 127)];
                        const size_t tb = (((size_t)(b * 4 + head) * 32 + (s >> 7)) * 128 + j0) * 128 + (s & 7);
                        const int tc = (s & 127) >> 3;
#pragma unroll
                        for (int e = 0; e < 8; ++e) { const int sw = ((tc ^ ((j0 + e) & 15)) << 3);
                            KFT[tb + (size_t)e * 128 + sw] = f2bf(o1[e] * dd[2]); KFT[tb + (size_t)(64 + e) * 128 + sw] = f2bf(o2[e] * dd[2]);
                        }
                    }
                } else if (pn < 6) {
                    const int h0 = 2 * (pn - 4);
                    const size_t tb = (((size_t)(b * 4 + h0) * 32 + (s >> 7)) * 128 + p0) * 128 + (s & 7);
                    const int tc = (s & 127) >> 3;
#pragma unroll
                    for (int e = 0; e < 8; ++e) { const int sw = ((tc ^ ((p0 + e) & 15)) << 3); VRT[tb + (size_t)e * 128 + sw] = f2bf(lo[e]); VRT[tb + (size_t)32 * 16384 + (size_t)e * 128 + sw] = f2bf(hi[e]); }
                } else if (pn < 8) {
#pragma unroll
                    for (int e = 0; e < 8; ++e) { lo[e] = lo[e] * sigm(lo[e]); hi[e] = hi[e] * sigm(hi[e]); }
                    bf16_t* gp = GR + (size_t)row * 512 + (pn - 6) * 256 + p0;
                    *(u32x4*)gp = pack8(lo); *(u32x4*)(gp + 128) = pack8(hi);
                } else if (pn < 10 || (pn == 10 && wc < 2)) {
                    const int j0 = p0 & 31;
                    float o1[8], o2[8];
                    const float sc = (pn < 10) ? 0.125f : 1.0f;
#pragma unroll
                    for (int q = 0; q < 4; ++q) { const f32x4 cs = tc[q];
                        o1[2 * q] = (lo[2 * q] * cs[0] - hi[2 * q] * cs[1]) * sc; o2[2 * q] = (lo[2 * q] * cs[1] + hi[2 * q] * cs[0]) * sc;
                        o1[2 * q + 1] = (lo[2 * q + 1] * cs[2] - hi[2 * q + 1] * cs[3]) * sc; o2[2 * q + 1] = (lo[2 * q + 1] * cs[3] + hi[2 * q + 1] * cs[2]) * sc; }
                    if (pn < 10) { bf16_t* dp = QA + (size_t)row * 512 + (4 * (pn - 8) + (p0 >> 5)) * 64 + j0; *(u32x4*)dp = pack8(o1); *(u32x4*)(dp + 32) = pack8(o2); }
                    else {
                        bf16_t* dp = KA + ((((size_t)(b * 2 + (p0 >> 5)) * 32 + (s >> 7)) * 128 + (s & 127)) << 6); const int sw = ((s & 127) >> 1) & 7;
                        *(u32x4*)(dp + (((j0 >> 3) ^ sw) << 3)) = pack8(o1); *(u32x4*)(dp + ((((j0 >> 3) + 4) ^ sw) << 3)) = pack8(o2); }
                } else if (pn == 10) {
                    const int d0 = p0 - 64;
                    const size_t tb = (((size_t)(b * 2) * 32 + (s >> 7)) * 64 + d0) * 128 + (s & 7);
                    const int tc = (s & 127) >> 3;
#pragma unroll
                    for (int e = 0; e < 8; ++e) { const int sw = ((tc ^ ((d0 + e) & 15)) << 3); VAT[tb + (size_t)e * 128 + sw] = f2bf(lo[e]); VAT[tb + (size_t)32 * 8192 + (size_t)e * 128 + sw] = f2bf(hi[e]); }
                } else {
#pragma unroll
                    for (int e = 0; e < 8; ++e) { lo[e] = sigm(lo[e]); hi[e] = sigm(hi[e]); }
                    unsigned char* gp = (ws + (pn < 15 ? OFF_SR : OFF_SA)) + (row * D + (pn < 15 ? pn - 11 : pn - 15) * 256 + p0);
                    if (pn >= 15) {
#pragma unroll
                        for (int e = 0; e < 8; ++e) { lo[e] = fmaxf(lo[e], 1.5f / 255.f); hi[e] = fmaxf(hi[e], 1.5f / 255.f); } }
                    u32x2 wl, wh;
                    wl.x = __builtin_amdgcn_cvt_pk_u8_f32(lo[3] * 255.f, 3, __builtin_amdgcn_cvt_pk_u8_f32(lo[2] * 255.f, 2, __builtin_amdgcn_cvt_pk_u8_f32(lo[1] * 255.f, 1, __builtin_amdgcn_cvt_pk_u8_f32(lo[0] * 255.f, 0, 0u))));
                    wl.y = __builtin_amdgcn_cvt_pk_u8_f32(lo[7] * 255.f, 3, __builtin_amdgcn_cvt_pk_u8_f32(lo[6] * 255.f, 2, __builtin_amdgcn_cvt_pk_u8_f32(lo[5] * 255.f, 1, __builtin_amdgcn_cvt_pk_u8_f32(lo[4] * 255.f, 0, 0u))));
                    wh.x = __builtin_amdgcn_cvt_pk_u8_f32(hi[3] * 255.f, 3, __builtin_amdgcn_cvt_pk_u8_f32(hi[2] * 255.f, 2, __builtin_amdgcn_cvt_pk_u8_f32(hi[1] * 255.f, 1, __builtin_amdgcn_cvt_pk_u8_f32(hi[0] * 255.f, 0, 0u))));
                    wh.y = __builtin_amdgcn_cvt_pk_u8_f32(hi[7] * 255.f, 3, __builtin_amdgcn_cvt_pk_u8_f32(hi[6] * 255.f, 2, __builtin_amdgcn_cvt_pk_u8_f32(hi[5] * 255.f, 1, __builtin_amdgcn_cvt_pk_u8_f32(hi[4] * 255.f, 0, 0u))));
                    *(u32x2*)gp = wl; *(u32x2*)(gp + 128) = wh;
                }
            }
    }
};

struct MapFfnIn { __device__ __forceinline__ int operator()(int n) const { const int r = n & 255, ffi = (n >> 8) * 128 + (r & 127); if (ffi >= FF) return -1; return r < 128 ? ffi : FF + ffi; } };
struct MapNat { __device__ __forceinline__ int operator()(int n) const { return n; } };
struct MapWin { __device__ __forceinline__ int operator()(int n) const {
    const int t = n >> 8, r = n & 255, rl = r & 127, hf = r >> 7;
    if (t < 2) return (2 * t + (rl >> 6)) * 128 + hf * 64 + (rl & 63);
    if (t < 4) return 512 + (2 * (t - 2) + (rl >> 6)) * 128 + hf * 64 + (rl & 63);
    if (t < 8) return 1024 + (t - 4) * 256 + r;
    if (t < 10) return 2048 + (4 * (t - 8) + (rl >> 5)) * 64 + hf * 32 + (rl & 31);
    if (t == 10) { if (rl < 64) return 2560 + (rl >> 5) * 64 + hf * 32 + (rl & 31); return 2688 + hf * 64 + (rl - 64); }
    return 2816 + (t - 11) * 256 + r;
} };

template <class Map>
__device__ __forceinline__ void tr_item(const float* W, int Ksrc, int Nsrc, bf16_t* WT, int Kdst, const float* gain, LAS float* scr, int kb, int nb, int lane, Map map) {
    const int k0 = 64 * kb, n0 = 32 * nb, sc = map(n0);
    const bool valid = (sc >= 0) && (k0 < Ksrc);
    float tv[32];
#pragma unroll
    for (int i = 0; i < 32; ++i) { const int kk = 2 * i + (lane >> 5); tv[i] = valid ? W[(size_t)(k0 + kk) * Nsrc + sc + (lane & 31)] : 0.f; }
#pragma unroll
    for (int i = 0; i < 32; ++i) { const int kk = 2 * i + (lane >> 5); scr[kk * 33 + (lane & 31)] = tv[i]; }
    asm volatile("s_waitcnt vmcnt(0) lgkmcnt(0)" ::: "memory");
    const int c = lane & 7;
    float gk[8];
#pragma unroll
    for (int e = 0; e < 8; ++e) gk[e] = (gain && valid) ? gain[k0 + 8 * c + e] : 1.f;
#pragma unroll
    for (int j = 0; j < 4; ++j) { const int n = (lane >> 3) + 8 * j; const LAS float* sp = scr + (8 * c) * 33 + n;
        float v[8];
#pragma unroll
        for (int e = 0; e < 8; ++e) v[e] = sp[e * 33] * gk[e];
        *(u32x4*)(WT + (size_t)(n0 + n) * Kdst + k0 + 8 * c) = pack8(v); }
    asm volatile("s_waitcnt lgkmcnt(0)" ::: "memory");
}

__device__ __forceinline__ void p0_prologue(const Params& P, LAS unsigned char* lds, int wid, int lane) {
    unsigned char* ws = P.ws;
    LAS float* scr = (LAS float*)(lds + wid * 16384);
    const int G = gridDim.x, gw = blockIdx.x * 8 + wid, NGW = G * 8, gt = blockIdx.x * 512 + threadIdx.x, NT = G * 512;
    constexpr int I_FI = 16 * (NFF2 / 32), I_FO = (FFP / 64) * 32, I_IN = 16 * (NIN / 32), I_RO = 8 * 32, I_OUT = 16 * 32;
    constexpr int NITEMS = 2 * I_FI + 2 * I_FO + I_IN + 2 * I_RO + I_OUT;
    for (int it = gw; it < NITEMS; it += NGW) {
        int r = it;
        if (r < I_FI) { tr_item(P.w1i, D, 2 * FF, (bf16_t*)(ws + OFF_W1T), D, P.g1, scr, r / (NFF2 / 32), r % (NFF2 / 32), lane, MapFfnIn()); continue; } r -= I_FI;
        if (r < I_FI) { tr_item(P.w2i, D, 2 * FF, (bf16_t*)(ws + OFF_W2T), D, P.g2, scr, r / (NFF2 / 32), r % (NFF2 / 32), lane, MapFfnIn()); continue; } r -= I_FI;
        if (r < I_FO) { tr_item(P.w1o, FF, D, (bf16_t*)(ws + OFF_W1O), FFP, nullptr, scr, r / 32, r % 32, lane, MapNat()); continue; } r -= I_FO;
        if (r < I_FO) { tr_item(P.w2o, FF, D, (bf16_t*)(ws + OFF_W2O), FFP, nullptr, scr, r / 32, r % 32, lane, MapNat()); continue; } r -= I_FO;
        if (r < I_IN) { tr_item(P.win, D, NIN, (bf16_t*)(ws + OFF_WIN), D, P.gmix, scr, r / (NIN / 32), r % (NIN / 32), lane, MapWin()); continue; } r -= I_IN;
        if (r < I_RO) { tr_item(P.wret, 512, D, (bf16_t*)(ws + OFF_WRET), 512, nullptr, scr, r / 32, r % 32, lane, MapNat()); continue; } r -= I_RO;
        if (r < I_RO) { tr_item(P.watt, 512, D, (bf16_t*)(ws + OFF_WATT), 512, nullptr, scr, r / 32, r % 32, lane, MapNat()); continue; } r -= I_RO;
        tr_item(P.wout, D, D, (bf16_t*)(ws + OFF_WOUT), D, nullptr, scr, r / 32, r % 32, lane, MapNat());
    }
    float* ss = (float*)(ws + OFF_SS);
    bf16_t* XB = (bf16_t*)(ws + OFF_XB);
    for (int row0 = gw; row0 < T; row0 += 4 * NGW) {
        f32x4 v[4][4];
#pragma unroll
        for (int r = 0; r < 4; ++r) { const f32x4* xr = (const f32x4*)(P.x + (size_t)(row0 + r * NGW) * D) + lane;
#pragma unroll
            for (int j = 0; j < 4; ++j) v[r][j] = xr[64 * j]; }
#pragma unroll
        for (int r = 0; r < 4; ++r) { const int row = row0 + r * NGW; float sq = 0.f;
#pragma unroll
            for (int j = 0; j < 4; ++j) sq += (v[r][j][0] * v[r][j][0] + v[r][j][1] * v[r][j][1]) + (v[r][j][2] * v[r][j][2] + v[r][j][3] * v[r][j][3]);
#pragma unroll
            for (int o = 1; o < 64; o <<= 1) sq += __shfl_xor(sq, o);
            u32x2* o8 = (u32x2*)(XB + (size_t)row * D) + lane;
#pragma unroll
            for (int j = 0; j < 4; ++j) { u32x2 w; w.x = cvt_pk_bf16(v[r][j][0], v[r][j][1]); w.y = cvt_pk_bf16(v[r][j][2], v[r][j][3]); o8[64 * j] = w; }
            if (lane == 0) ss[row] = sq; }
    }
    for (int i = gt; i < 3 * T; i += NT) ss[T + i] = 0.f;
    f32x2* tabR = (f32x2*)(ws + OFF_TABR); f32x2* tabA = (f32x2*)(ws + OFF_TABA);
    const double L2T = 13.287712379549449;
    const double INV2PI = 0.15915494309189535;
    for (int i = gt; i < SEQ * 64; i += NT) { const int s = i >> 6, j = i & 63; const float invf = (float)exp2(-(double)j * (1.0 / 64.0) * L2T);
        const float ang = (float)s * invf; double rev = (double)ang * INV2PI; rev -= rint(rev);
        tabR[i] = (f32x2){__builtin_amdgcn_cosf((float)rev), __builtin_amdgcn_sinf((float)rev)}; }
    for (int i = gt; i < SEQ * 32; i += NT) { const int s = i >> 5, j = i & 31; const float invf = (float)exp2(-(double)j * (1.0 / 32.0) * L2T);
        const float ang = (float)s * invf; double rev = (double)ang * INV2PI; rev -= rint(rev);
        tabA[i] = (f32x2){__builtin_amdgcn_cosf((float)rev), __builtin_amdgcn_sinf((float)rev)}; }
    { float* sm = (float*)(ws + OFF_SM);
      if (gt < 4) { sm[gt] = -expf(P.dfw[gt]); sm[4 + gt] = -expf(P.dbw[gt]); }
      if (gt < 8) sm[8 + gt] = P.sink[gt];
      if (gt < 512) sm[64 + gt] = P.gng[gt]; }
    if (gt < 512) { const int h = gt >> 7, i = gt & 127; const float lgf = -expf(P.dfw[h]), lgb = -expf(P.dbw[h]);
        ((f32x4*)(ws + OFF_DT))[gt] = (f32x4){expf(lgf * (float)(i + 1)), expf(lgb * (float)(128 - i)), expf(lgf * (float)(127 - i)), expf(lgb * (float)i)}; }
}

__device__ __forceinline__ void attn_unit(unsigned char* ws, LAS unsigned char* lds, int u, int wid, int lane) {
    asm volatile("" : "+v"(lane));
    const int blk = u & 31, bk = u >> 5, hk = bk & 1, b = bk >> 1, fr = lane & 15, g = lane >> 4;
    bf16_t* QA = (bf16_t*)(ws + OFF_QA);
    const char* srcK = (const char*)(ws + OFF_KA) + ((size_t)bk * 32 + (blk - 1)) * 16384;
    const char* srcV = (const char*)(ws + OFF_VAT) + ((size_t)bk * 32 + (blk - 1)) * 16384;
    __syncthreads();
#pragma unroll
    for (int j = 0; j < 6; ++j) { const int piece = j * 8 + wid, pbk = piece >> 4; const int gb = blk - 1 + pbk;
        if (gb >= 0 && gb < 32) { const size_t go = (size_t)piece * 1024 + lane * 16;
            __builtin_amdgcn_global_load_lds((const unsigned*)(srcK + go), (LAS unsigned*)(lds + piece * 1024), 16, 0, 0);
            __builtin_amdgcn_global_load_lds((const unsigned*)(srcV + go), (LAS unsigned*)(lds + 49152 + piece * 1024), 16, 0, 0); } }
    const int q0 = blk * 128 + wid * 16, n = q0 + fr;
    asm volatile("s_waitcnt vmcnt(0)" ::: "memory");
    __syncthreads();
    const LAS unsigned char* krow = lds + fr * 128;
    const LAS unsigned char* vrow = lds + 49152 + fr * 256 + 8 * (g & 1);
#pragma unroll 1
    for (int hp = 0; hp < 2; ++hp) {
        const int head0 = hk * 4 + 2 * hp;
        bf16_t* qp = QA + ((size_t)(b * SEQ + q0 + fr)) * 512 + head0 * 64;
        bf16x8 bq[2][2];
#pragma unroll
        for (int hh = 0; hh < 2; ++hh) { bq[hh][0] = *(const bf16x8*)(qp + hh * 64 + 8 * g); bq[hh][1] = *(const bf16x8*)(qp + hh * 64 + 32 + 8 * g); }
        float m_run[2], l_run[2];
        f32x4 o[2][4];
#pragma unroll
        for (int hh = 0; hh < 2; ++hh) { m_run[hh] = ((const float*)(ws + OFF_SM))[8 + head0 + hh]; l_run[hh] = (g == 0) ? 1.f : 0.f;
#pragma unroll
            for (int rb = 0; rb < 4; ++rb) o[hh][rb] = (f32x4){0.f, 0.f, 0.f, 0.f}; }
#pragma unroll 1
        for (int gq = 0; gq < 3; ++gq) {
            const int kl0 = 16 * wid + 96 * gq;
            const int key0 = q0 - 128 + 96 * gq;
            bf16x8 ka[6][2]; bf16x4 vv[3][4][2]; bool inb[6];
#pragma unroll
            for (int bl = 0; bl < 6; ++bl) { const int kl = kl0 + 16 * bl, kp0 = key0 + 16 * bl; inb[bl] = (kp0 >= 0) && (kp0 < SEQ);
                const LAS unsigned char* kp = krow + (kl >> 7) * 16384 + (kl & 127) * 128;
                ka[bl][0] = *(const LAS bf16x8*)(kp + ((g ^ (fr >> 1)) << 4)); ka[bl][1] = *(const LAS bf16x8*)(kp + (((4 + g) ^ (fr >> 1)) << 4)); }
#pragma unroll
            for (int t = 0; t < 3; ++t)
#pragma unroll
                for (int hf = 0; hf < 2; ++hf) { const int kl = kl0 + 16 * (2 * t + hf); const int vb = inb[2 * t + hf] ? (kl >> 7) : 1;
                    const LAS unsigned char* vp = vrow + vb * 16384 + (((((kl & 127) >> 3) + (g >> 1)) ^ fr) << 4);
#pragma unroll
                    for (int rb = 0; rb < 4; ++rb) vv[t][rb][hf] = *(const LAS bf16x4*)(vp + rb * 4096); }
#pragma unroll
            for (int hh = 0; hh < 2; ++hh) {
                float p[6][4]; float mx = -INFINITY;
#pragma unroll
                for (int bl = 0; bl < 6; ++bl) {
                    f32x4 sacc = (f32x4){0.f, 0.f, 0.f, 0.f};
                    sacc = MFMA16(ka[bl][0], bq[hh][0], sacc); sacc = MFMA16(ka[bl][1], bq[hh][1], sacc);
#pragma unroll
                    for (int i = 0; i < 4; ++i) { const int dd = n - (key0 + 16 * bl + 4 * g + i); const bool ok = inb[bl] && dd <= 128 && dd >= -128; p[bl][i] = ok ? sacc[i] : -INFINITY; mx = fmaxf(mx, p[bl][i]); }
                }
                mx = fmaxf(mx, __shfl_xor(mx, 16)); mx = fmaxf(mx, __shfl_xor(mx, 32));
                const float m_new = fmaxf(m_run[hh], mx), alpha = __expf(m_run[hh] - m_new);
                float ps = 0.f;
#pragma unroll
                for (int bl = 0; bl < 6; ++bl)
#pragma unroll
                    for (int i = 0; i < 4; ++i) { p[bl][i] = __expf(p[bl][i] - m_new); ps += p[bl][i]; }
                l_run[hh] = l_run[hh] * alpha + ps; m_run[hh] = m_new;
#pragma unroll
                for (int rb = 0; rb < 4; ++rb) o[hh][rb] = o[hh][rb] * alpha;
#pragma unroll
                for (int t = 0; t < 3; ++t) {
                    u32x4 pw; pw.x = cvt_pk_bf16(p[2 * t][0], p[2 * t][1]); pw.y = cvt_pk_bf16(p[2 * t][2], p[2 * t][3]); pw.z = cvt_pk_bf16(p[2 * t + 1][0], p[2 * t + 1][1]); pw.w = cvt_pk_bf16(p[2 * t + 1][2], p[2 * t + 1][3]);
                    const bf16x8 pb = __builtin_bit_cast(bf16x8, pw);
#pragma unroll
                    for (int rb = 0; rb < 4; ++rb) { const bf16x8 va = __builtin_shufflevector(vv[t][rb][0], vv[t][rb][1], 0, 1, 2, 3, 4, 5, 6, 7); o[hh][rb] = MFMA16(va, pb, o[hh][rb]); }
                }
            }
        }
#pragma unroll
        for (int hh = 0; hh < 2; ++hh) {
            float l = l_run[hh]; l += __shfl_xor(l, 16); l += __shfl_xor(l, 32);
            const float inv = 1.f / l;
#pragma unroll
            for (int rb = 0; rb < 4; ++rb) { u32x2 w; w.x = cvt_pk_bf16(o[hh][rb][0] * inv, o[hh][rb][1] * inv); w.y = cvt_pk_bf16(o[hh][rb][2] * inv, o[hh][rb][3] * inv);
                *(u32x2*)(qp + hh * 64 + 16 * rb + 4 * g) = w; }
        }
    }
}

__device__ __forceinline__ void r12_unit(unsigned char* ws, bf16_t* kvs, LAS unsigned char* lds, int u, int wid, int lane) {
    asm volatile("" : "+v"(lane));
    const int slice = u & 3, dir = (u >> 2) & 1, bh = u >> 3, h = bh & 3, fr = lane & 15, g = lane >> 4;
    const float gc = expf(128.f * ((const float*)(ws + OFF_SM))[4 * dir + h]);
    const char* KT = (const char*)(ws + OFF_KFT) + (size_t)bh * 32 * 32768 + lane * 16;
    const char* VT = (const char*)(ws + OFF_VRT) + (size_t)bh * 32 * 32768 + slice * 8192 + wid * 1024 + lane * 16;
    bf16_t* SO = kvs + ((size_t)bh * 64 + dir) * 16384 + (32 * slice + fr) * 128 + (((2 * wid + (g >> 1)) ^ fr) << 3) + 4 * (g & 1);
    const int c0 = dir ? 31 : 0, cs = dir ? -1 : 1;
    constexpr int STG = 40960;
#define R12_DMA(i) do { const int _c = c0 + (i) * cs; LAS unsigned char* _st = lds + ((i) % 3) * STG; \
        _Pragma("unroll") for (int _j = 0; _j < 4; ++_j) __builtin_amdgcn_global_load_lds((const unsigned*)(KT + (size_t)_c * 32768 + (_j * 8 + wid) * 1024), (LAS unsigned*)(_st + (_j * 8 + wid) * 1024), 16, 0, 0); \
        __builtin_amdgcn_global_load_lds((const unsigned*)(VT + (size_t)_c * 32768), (LAS unsigned*)(_st + 32768 + wid * 1024), 16, 0, 0); } while (0)
    f32x4 S[2] = {(f32x4){0.f, 0.f, 0.f, 0.f}, (f32x4){0.f, 0.f, 0.f, 0.f}};
    float rt[4][8];
    { const float lgf = ((const float*)(ws + OFF_SM))[h], lgb = ((const float*)(ws + OFF_SM))[4 + h];
#pragma unroll
      for (int ks = 0; ks < 4; ++ks)
#pragma unroll
          for (int e = 0; e < 8; ++e) { const float j = (float)(32 * ks + 8 * g + e); rt[ks][e] = dir ? __expf(lgb * j - lgf * (127.f - j)) : 1.f; } }
    asm volatile("s_waitcnt vmcnt(0)" ::: "memory");
    __builtin_amdgcn_s_barrier();
    R12_DMA(0); R12_DMA(1);
    const unsigned aoff = (16 * wid + fr) * 256, boff = 32768 + fr * 256;
#pragma unroll 1
    for (int i = 0; i < 32; ++i) {
        if (i + 2 < 32) R12_DMA(i + 2);
        if (i == 0) asm volatile("s_waitcnt vmcnt(10)" ::: "memory");
        else if (i == 1) asm volatile("s_waitcnt vmcnt(12)" ::: "memory");
        else if (i < 30) asm volatile("s_waitcnt vmcnt(14)" ::: "memory");
        else asm volatile("s_waitcnt vmcnt(4)" ::: "memory");
        __builtin_amdgcn_s_barrier();
        asm volatile("" ::: "memory");
        const LAS unsigned char* st = lds + (i % 3) * STG;
        const int c = c0 + i * cs;
#pragma unroll
        for (int cb = 0; cb < 2; ++cb) { u32x2 w; w.x = cvt_pk_bf16(S[cb][0], S[cb][1]); w.y = cvt_pk_bf16(S[cb][2], S[cb][3]); *(u32x2*)(SO + (size_t)c * 32768 + cb * 2048) = w; }
        f32x4 kv0 = (f32x4){0.f, 0.f, 0.f, 0.f}, kv1 = kv0;
#pragma unroll
        for (int ks = 0; ks < 4; ++ks) { const int sw = (((4 * ks + g) ^ fr) << 4);
            bf16x8 a = *(const LAS bf16x8*)(st + aoff + sw); const bf16x8 b0 = *(const LAS bf16x8*)(st + boff + sw), b1 = *(const LAS bf16x8*)(st + boff + 4096 + sw);
            if (dir) { const u32x4 aw = __builtin_bit_cast(u32x4, a); u32x4 ow;
                ow.x = cvt_pk_bf16(bflo(aw.x) * rt[ks][0], bfhi(aw.x) * rt[ks][1]); ow.y = cvt_pk_bf16(bflo(aw.y) * rt[ks][2], bfhi(aw.y) * rt[ks][3]);
                ow.z = cvt_pk_bf16(bflo(aw.z) * rt[ks][4], bfhi(aw.z) * rt[ks][5]); ow.w = cvt_pk_bf16(bflo(aw.w) * rt[ks][6], bfhi(aw.w) * rt[ks][7]);
                a = __builtin_bit_cast(bf16x8, ow); }
            kv0 = MFMA16(a, b0, kv0); kv1 = MFMA16(a, b1, kv1); }
        S[0] = S[0] * gc + kv0; S[1] = S[1] * gc + kv1;
        asm volatile("s_waitcnt lgkmcnt(0)" ::: "memory");
        __builtin_amdgcn_s_barrier();
        asm volatile("" ::: "memory");
    }
#undef R12_DMA
    asm volatile("s_waitcnt vmcnt(0)" ::: "memory");
}

__device__ __forceinline__ void r3_unit(unsigned char* ws, const bf16_t* kvs, LAS unsigned char* lds, int u, int wid, int lane) {
    asm volatile("" : "+v"(lane));
    const int c = u & 31, bh = u >> 5, h = bh & 3, b = bh >> 2, fr = lane & 15, g = lane >> 4;
    bf16_t* QR = (bf16_t*)(ws + OFF_QR); const bf16_t* GR = (const bf16_t*)(ws + OFF_GR);
    const char* srcK = (const char*)(ws + OFF_KR) + ((size_t)bh * 32 + c) * 32768;
    const char* srcV = (const char*)(ws + OFF_VRT) + ((size_t)bh * 32 + c) * 32768;
    const char* srcS = (const char*)kvs + ((size_t)bh * 32 + c) * 65536;
    __syncthreads();
#pragma unroll
    for (int j = 0; j < 4; ++j) { const int piece = j * 8 + wid; const size_t go = (size_t)piece * 1024 + lane * 16;
        __builtin_amdgcn_global_load_lds((const unsigned*)(srcK + go), (LAS unsigned*)(lds + piece * 1024), 16, 0, 0);
        __builtin_amdgcn_global_load_lds((const unsigned*)(srcV + go), (LAS unsigned*)(lds + 32768 + piece * 1024), 16, 0, 0);
        __builtin_amdgcn_global_load_lds((const unsigned*)(srcS + go), (LAS unsigned*)(lds + 65536 + piece * 1024), 16, 0, 0);
        __builtin_amdgcn_global_load_lds((const unsigned*)(srcS + 32768 + go), (LAS unsigned*)(lds + 98304 + piece * 1024), 16, 0, 0); }
    const int nq = 16 * wid + fr;
    const size_t tokq = (size_t)b * SEQ + c * 128 + nq;
    bf16_t* qp = QR + tokq * 512 + h * 128;
    bf16x8 bq[4];
#pragma unroll
    for (int ks = 0; ks < 4; ++ks) bq[ks] = *(const bf16x8*)(qp + 32 * ks + 8 * g);
    const float lgf = ((const float*)(ws + OFF_SM))[h], lgb = ((const float*)(ws + OFF_SM))[4 + h];
    const f32x4 dq = ((const f32x4*)(ws + OFF_DT))[h * 128 + nq];
    asm volatile("s_waitcnt vmcnt(0)" ::: "memory");
    __syncthreads();
    const LAS unsigned char* rowp = lds + fr * 256;
    bf16x8 pb[4];
#pragma unroll
    for (int kt = 0; kt < 4; ++kt) {
        float pv[8];
#pragma unroll
        for (int hf = 0; hf < 2; ++hf) {
            const int kb = 2 * kt + hf;
            f32x4 sacc = (f32x4){0.f, 0.f, 0.f, 0.f};
#pragma unroll
            for (int ks = 0; ks < 4; ++ks) { const bf16x8 a = *(const LAS bf16x8*)(rowp + kb * 4096 + (((4 * ks + g) ^ fr) << 4)); sacc = MFMA16(a, bq[ks], sacc); }
#pragma unroll
            for (int i = 0; i < 4; ++i) { const int dd = nq - (16 * kb + 4 * g + i); const float dec = dd >= 0 ? __expf(lgf * (float)dd) : __expf(lgb * (float)(-dd)); pv[4 * hf + i] = sacc[i] * dec; }
        }
        pb[kt] = __builtin_bit_cast(bf16x8, pack8(pv));
        __builtin_amdgcn_sched_barrier(0);
    }
    f32x4 y[8];
    float sum = 0.f;
#pragma unroll
    for (int rb = 0; rb < 8; ++rb) {
        f32x4 ya = (f32x4){0.f, 0.f, 0.f, 0.f}, cf = ya, cbk = ya;
#pragma unroll
        for (int kt = 0; kt < 4; ++kt) {
            const bf16x4 v0 = *(const LAS bf16x4*)(rowp + 32768 + rb * 4096 + (((4 * kt + (g >> 1)) ^ fr) << 4) + 8 * (g & 1));
            const bf16x4 v1 = *(const LAS bf16x4*)(rowp + 32768 + rb * 4096 + (((4 * kt + 2 + (g >> 1)) ^ fr) << 4) + 8 * (g & 1));
            const bf16x8 va = __builtin_shufflevector(v0, v1, 0, 1, 2, 3, 4, 5, 6, 7); ya = MFMA16(va, pb[kt], ya); }
#pragma unroll
        for (int ks = 0; ks < 4; ++ks) { const int so = rb * 4096 + (((4 * ks + g) ^ fr) << 4);
            const bf16x8 af = *(const LAS bf16x8*)(rowp + 65536 + so), ab = *(const LAS bf16x8*)(rowp + 98304 + so);
            cf = MFMA16(af, bq[ks], cf); cbk = MFMA16(ab, bq[ks], cbk); }
        y[rb] = ya + cf * dq[0] + cbk * dq[1];
        sum += (y[rb][0] + y[rb][1]) + (y[rb][2] + y[rb][3]);
        __builtin_amdgcn_sched_barrier(0);
    }
    sum += __shfl_xor(sum, 16); sum += __shfl_xor(sum, 32);
    const float mu = sum * (1.f / 128.f);
    float var = 0.f;
#pragma unroll
    for (int rb = 0; rb < 8; ++rb) { y[rb] = y[rb] - mu; var += (y[rb][0] * y[rb][0] + y[rb][1] * y[rb][1]) + (y[rb][2] * y[rb][2] + y[rb][3] * y[rb][3]); }
    var += __shfl_xor(var, 16); var += __shfl_xor(var, 32);
    const float rstd = rsqrtf(var * (1.f / 128.f) + EPS);
    const bf16_t* gp = GR + tokq * 512 + h * 128 + 4 * g;
    const float* gn = (const float*)(ws + OFF_SM) + 64 + h * 128 + 4 * g;
#pragma unroll
    for (int rb = 0; rb < 8; ++rb) {
        const u32x2 gw = *(const u32x2*)(gp + 16 * rb); const f32x4 gg = *(const f32x4*)(gn + 16 * rb);
        const float v0 = y[rb][0] * rstd * gg[0] * bflo(gw.x), v1 = y[rb][1] * rstd * gg[1] * bfhi(gw.x), v2 = y[rb][2] * rstd * gg[2] * bflo(gw.y), v3 = y[rb][3] * rstd * gg[3] * bfhi(gw.y);
        u32x2 w; w.x = cvt_pk_bf16(v0, v1); w.y = cvt_pk_bf16(v2, v3);
        *(u32x2*)(qp + 16 * rb + 4 * g) = w;
    }
}


#define XB_TMO      128
#define XB_XCNT(j)  (256  + 64 * (j))
#define XB_XSUB(j)  (1280 + 64 * (j))
#define XB_XGEN(j)  (2304 + 64 * (j))
#define XB_TOP      3328
#define XB_TOPGEN   3392
#define XCD_BAR_WORDS 3456
#define XB_SPIN_CAP (1u << 22)
__device__ __forceinline__ unsigned xb_ld(unsigned* p)              { return __hip_atomic_load(p, __ATOMIC_RELAXED, __HIP_MEMORY_SCOPE_AGENT); }
__device__ __forceinline__ unsigned xb_add(unsigned* p, unsigned v) { return __hip_atomic_fetch_add(p, v, __ATOMIC_RELAXED, __HIP_MEMORY_SCOPE_AGENT); }
__device__ __forceinline__ unsigned xb_xcc_id() { return (unsigned)__builtin_amdgcn_s_getreg((3 << 11) | 20) & 0xFu; }
#define XB_SPIN(cond, bar) do { unsigned _sp = 0; while (cond) { __builtin_amdgcn_s_sleep(1); \
    if ((++_sp & 255u) == 0u) { if (xb_ld(&(bar)[XB_TMO])) break; if (_sp > XB_SPIN_CAP) { atomicAdd(&(bar)[XB_TMO], 1u); break; } } } } while (0)
struct XcdBarrier { unsigned* bar; unsigned x; volatile LAS unsigned* st; };
__device__ __forceinline__ XcdBarrier xcd_barrier_post(unsigned* bar, volatile LAS unsigned* st) {
    XcdBarrier b; b.bar = bar; b.x = xb_xcc_id(); b.st = st;
    if (threadIdx.x == 0) (void)xb_add(&bar[XB_XCNT(b.x)], 1u);
    return b;
}
__device__ __forceinline__ void xcd_barrier_complete(unsigned* bar, unsigned x, unsigned& nloc, unsigned& nx) {
    const unsigned G = gridDim.x * gridDim.y * gridDim.z;
    unsigned sum, cnt, mine, sp = 0u;
    for (;;) {
        sum = 0u; cnt = 0u; mine = 0u;
#pragma unroll
        for (unsigned j = 0; j < 16; ++j) { const unsigned c = xb_ld(&bar[XB_XCNT(j)]); sum += c; cnt += (c > 0u) ? 1u : 0u; mine = (j == x) ? c : mine; }
        if (sum == G) break;
        __builtin_amdgcn_s_sleep(1);
        if ((++sp & 255u) == 0u) { if (xb_ld(&bar[XB_TMO])) break; if (sp > XB_SPIN_CAP) { atomicAdd(&bar[XB_TMO], 1u); break; } }
    }
    nloc = mine > 0u ? mine : 1u; nx = cnt > 0u ? cnt : 1u;
}
__device__ __forceinline__ void xcd_barrier(const XcdBarrier& b) {
    asm volatile("s_waitcnt vmcnt(0)" ::: "memory");
    __syncthreads();
    if (threadIdx.x == 0) {
        unsigned* bar = b.bar;
        __builtin_amdgcn_s_waitcnt(0);
        unsigned nloc = b.st[0], nx = b.st[1];
        if (nloc == 0u) { xcd_barrier_complete(bar, b.x, nloc, nx); b.st[0] = nloc; b.st[1] = nx; }
        const unsigned old = xb_add(&bar[XB_XSUB(b.x)], 1u);
        const unsigned gen = old / nloc;
        if (old + 1u == (gen + 1u) * nloc) {
            __builtin_amdgcn_fence(__ATOMIC_RELEASE, "agent");
            asm volatile("s_waitcnt vmcnt(0)" ::: "memory");
            const unsigned og = xb_add(&bar[XB_TOP], 1u);
            const unsigned tg = og / nx;
            if (og + 1u == (tg + 1u) * nx) xb_add(&bar[XB_TOPGEN], 1u);
            else XB_SPIN(xb_ld(&bar[XB_TOPGEN]) == tg, bar);
            __builtin_amdgcn_fence(__ATOMIC_ACQUIRE, "agent");
            xb_add(&bar[XB_XGEN(b.x)], 1u);
            asm volatile("s_waitcnt vmcnt(0)" ::: "memory");
        } else {
            XB_SPIN(xb_ld(&bar[XB_XGEN(b.x)]) == gen, bar);
            __builtin_amdgcn_fence(__ATOMIC_ACQUIRE, "agent");
            asm volatile("s_waitcnt vmcnt(0)" ::: "memory");
        }
    }
    __syncthreads();
}

__global__ void __launch_bounds__(512, 2) fwd_megakernel(Params P) {
    extern __shared__ __attribute__((aligned(16))) unsigned char lds_raw[];
    LAS unsigned char* lds = (LAS unsigned char*)lds_raw;
    cg::grid_group grid = cg::this_grid();
    const int tid = threadIdx.x, G = gridDim.x;
#define LANE_ ((int)(threadIdx.x & 63))
#define WID_ (__builtin_amdgcn_readfirstlane((int)(threadIdx.x >> 6)))
    unsigned char* ws = P.ws;
    float* ss = (float*)(ws + OFF_SS);
    bf16_t* XB = (bf16_t*)(ws + OFF_XB); bf16_t* H = (bf16_t*)(ws + OFF_BIG);
    pg8::StaticOrder S;

#define GSYNC() do { asm volatile("s_waitcnt vmcnt(0) lgkmcnt(0)" ::: "memory"); __syncthreads(); grid.sync(); \
        __builtin_amdgcn_fence(__ATOMIC_ACQUIRE, "agent"); asm volatile("s_waitcnt vmcnt(0)" ::: "memory"); __syncthreads(); } while (0)
    volatile LAS unsigned* bst = (volatile LAS unsigned*)(lds + 131072);
    if (tid < 4) bst[tid] = 0u;
    __syncthreads();
    XcdBarrier xbar = xcd_barrier_post((unsigned*)(ws + OFF_BARW), bst);
    if (P.ws == nullptr) GSYNC();
#undef GSYNC
#define GSYNC() xcd_barrier(xbar)
    p0_prologue(P, lds, WID_, LANE_);
    GSYNC();
    { pg8::Gemm g{XB, (const bf16_t*)(ws + OFF_W1T), T, NFF2, D}; S.init(T, NFF2, G, blockIdx.x); EpiSwiglu E{ws, 0}; pg8::gemm_phase(lds, g, S, E); }
    GSYNC();
    { pg8::Gemm g{H, (const bf16_t*)(ws + OFF_W1O), T, D, FFP}; S.init(T, D, G, blockIdx.x); EpiResid<false> E{nullptr, ws, 1, 0.5f}; pg8::gemm_phase(lds, g, S, E); }
    GSYNC();
    { pg8::Gemm g{XB, (const bf16_t*)(ws + OFF_WIN), T, NIN, D}; pg8::TailSplitOrder TS; TS.S.init(T, NIN, G, blockIdx.x);
      EpiProj E{ws};
      pg8::gemm_phase(lds, g, TS, E); }
    GSYNC();
    for (int u = blockIdx.x; u < 768; u += G) { if (u < 512) attn_unit(ws, lds, u, WID_, LANE_); else r12_unit(ws, (bf16_t*)P.out, lds, u - 512, WID_, LANE_); }
    asm volatile("s_waitcnt vmcnt(0)" ::: "memory"); __syncthreads();
    GSYNC();
    for (int u = blockIdx.x; u < 1024; u += G) r3_unit(ws, (const bf16_t*)P.out, lds, u, WID_, LANE_);
    asm volatile("s_waitcnt vmcnt(0)" ::: "memory"); __syncthreads();
    GSYNC();
    { pg8::PairOrder PO; PO.S.init(T, D, G, blockIdx.x);
      pg8::Gemm g{(const bf16_t*)(ws + OFF_QR), (const bf16_t*)(ws + OFF_WRET), T, D, 512, (const bf16_t*)(ws + OFF_QA), (const bf16_t*)(ws + OFF_WATT)};
      EpiGate E{ws}; pg8::gemm_phase(lds, g, PO, E); }
    GSYNC();
    { pg8::Gemm g{(const bf16_t*)(ws + OFF_MG), (const bf16_t*)(ws + OFF_WOUT), T, D, D}; S.init(T, D, G, blockIdx.x); EpiResid<false> E{nullptr, ws, 2, 1.0f}; pg8::gemm_phase(lds, g, S, E); }
    GSYNC();
    { pg8::Gemm g{XB, (const bf16_t*)(ws + OFF_W2T), T, NFF2, D}; S.init(T, NFF2, G, blockIdx.x); EpiSwiglu E{ws, 2}; pg8::gemm_phase(lds, g, S, E); }
    GSYNC();
    { pg8::Gemm g{H, (const bf16_t*)(ws + OFF_W2O), T, D, FFP}; S.init(T, D, G, blockIdx.x); EpiResid<false> E{nullptr, ws, 3, 0.5f}; pg8::gemm_phase(lds, g, S, E); }
    GSYNC();
    int lane9 = threadIdx.x & 63; asm volatile("" : "+v"(lane9));
    {
        const f32x4* gf = (const f32x4*)P.gfin + lane9;
        for (int row0 = blockIdx.x * 8 + WID_; row0 < T; row0 += G * 32) {
            u32x2 w[4][4]; float rs4[4];
#pragma unroll
            for (int r = 0; r < 4; ++r) { const int row = row0 + r * G * 8; rs4[r] = ss[3 * T + row]; const u32x2* xr = (const u32x2*)(XB + (size_t)row * D) + lane9;
#pragma unroll
                for (int j = 0; j < 4; ++j) w[r][j] = xr[64 * j]; }
            f32x4 gg[4];
#pragma unroll
            for (int j = 0; j < 4; ++j) gg[j] = gf[64 * j];
#pragma unroll
            for (int r = 0; r < 4; ++r) { const int row = row0 + r * G * 8; const float rstd = rsqrtf(rs4[r] * (1.f / 1024.f) + EPS); f32x4* o = (f32x4*)(P.out + (size_t)row * D) + lane9;
#pragma unroll
                for (int j = 0; j < 4; ++j) o[64 * j] = (f32x4){bflo(w[r][j].x), bfhi(w[r][j].x), bflo(w[r][j].y), bfhi(w[r][j].y)} * rstd * gg[j]; }
        }
    }
}

extern "C" void kernel_launch(void* const* d_in, const int* in_sizes, int n_in, void* d_out, int out_size, void* d_ws, size_t ws_size, hipStream_t stream) {
    constexpr int LDS_BYTES = pg8::STAGE_BYTES + 256;
    static int grid = 0;
    if (grid == 0) {
        if (n_in != 17 || in_sizes[0] != T * D || out_size != T * D || ws_size < WS_END) { fprintf(stderr, "kernel_launch: unexpected shapes (n_in %d, in0 %d, out %d, ws %zu < %zu)\n", n_in, n_in > 0 ? in_sizes[0] : -1, out_size, ws_size, (size_t)WS_END); grid = -1; return; }
        int dev = 0, cus = 0, per_cu = 0;
        (void)hipGetDevice(&dev);
        (void)hipDeviceGetAttribute(&cus, hipDeviceAttributeMultiprocessorCount, dev);
        if (hipFuncSetAttribute((const void*)fwd_megakernel, hipFuncAttributeMaxDynamicSharedMemorySize, LDS_BYTES) != hipSuccess) { fprintf(stderr, "kernel_launch: hipFuncSetAttribute failed\n"); grid = -1; return; }
        if (hipOccupancyMaxActiveBlocksPerMultiprocessor(&per_cu, (const void*)fwd_megakernel, 512, LDS_BYTES) != hipSuccess || per_cu < 1) { fprintf(stderr, "kernel_launch: occupancy query failed (%d)\n", per_cu); (void)hipGetLastError(); per_cu = 1; }
        grid = cus * per_cu;
        if (grid > 2048) grid = 2048;
    }
    if (grid < 0) return;
    if (hipMemsetAsync((char*)d_ws + OFF_BARW, 0, 16384, stream) != hipSuccess) { fprintf(stderr, "kernel_launch: memset of the barrier words failed\n"); return; }
    Params p{};
    p.x = (const float*)d_in[0]; p.g1 = (const float*)d_in[1]; p.w1i = (const float*)d_in[2]; p.w1o = (const float*)d_in[3]; p.gmix = (const float*)d_in[4]; p.win = (const float*)d_in[5];
    p.dfw = (const float*)d_in[6]; p.dbw = (const float*)d_in[7]; p.gng = (const float*)d_in[8]; p.wret = (const float*)d_in[9]; p.sink = (const float*)d_in[10]; p.watt = (const float*)d_in[11];
    p.wout = (const float*)d_in[12]; p.g2 = (const float*)d_in[13]; p.w2i = (const float*)d_in[14]; p.w2o = (const float*)d_in[15]; p.gfin = (const float*)d_in[16];
    p.out = (float*)d_out; p.ws = (unsigned char*)d_ws;
    void* args[] = {&p};
    hipError_t e = hipLaunchCooperativeKernel((const void*)fwd_megakernel, dim3(grid), dim3(512), args, LDS_BYTES, stream);
    if (e != hipSuccess) fprintf(stderr, "cooperative launch failed: %s (grid %d)\n", hipGetErrorString(e), grid);
}
```
